# Optimizing an MI355X kernel written in HIP

```python
import math
import jax, jax.numpy as jnp
from jax import lax
import numpy as np

D_MODEL = 2048
BATCH = 4
SEQ = 8192
DEPTH = 1

ATTN_WIDTH = D_MODEL // 2
HEAD_DIM = 64
N_DIFF_HEADS = ATTN_WIDTH // (2 * HEAD_DIM)
SSM_WIDTH = D_MODEL // 2
SSM_GROUP = 16
N_SSM_GROUPS = SSM_WIDTH // SSM_GROUP
SSM_STATE = 64
D_FF = -(-8 * D_MODEL // (3 * 256)) * 256
IN_COLS = 3 * ATTN_WIDTH + SSM_WIDTH + 2 * D_MODEL
Q_BLOCK = 128
EPS = 1e-6
DT_MIN = 1e-3
DT_MAX = 1e-1
NEG_INF = -1e30

kernel_name = "hybrid_diffattn_s5_gated_block"


def _rms_norm(x, w):
    xf = x.astype(jnp.float32)
    y = xf * lax.rsqrt(jnp.mean(xf * xf, axis=-1, keepdims=True) + EPS)
    return (y * w.astype(jnp.float32)).astype(x.dtype)


def _lambda_init(layer_idx):
    return 0.8 - 0.6 * math.exp(-0.3 * layer_idx)


def _diff_attention(q, k, v, lam, lam_init, subln_w):
    bsz, seq, n_heads, _, dh = q.shape
    e = v.shape[-1]
    scale = dh ** -0.5
    n_blocks = seq // Q_BLOCK
    kpos = jnp.arange(seq)

    def one_block(i):
        start = i * Q_BLOCK
        qb = lax.dynamic_slice_in_dim(q, start, Q_BLOCK, axis=1)
        s = jnp.einsum('bqhcd,bkhcd->bhcqk', qb, k).astype(jnp.float32) * scale
        qpos = start + jnp.arange(Q_BLOCK)
        causal = kpos[None, :] <= qpos[:, None]
        s = jnp.where(causal, s, NEG_INF)
        p = jax.nn.softmax(s, axis=-1)
        a = p[:, :, 0] - lam * p[:, :, 1]
        return jnp.einsum('bhqk,bkhe->bqhe', a.astype(v.dtype), v)

    o = lax.map(one_block, jnp.arange(n_blocks))
    o = jnp.moveaxis(o, 0, 1).reshape(bsz, seq, n_heads, e)
    o = _rms_norm(o, subln_w) * (1.0 - lam_init)
    return o.reshape(bsz, seq, n_heads * e)


def _ssm_binop(left, right):
    a1, b1 = left
    a2, b2 = right
    return a1 * a2, a2 * b1 + b2


def _s5_groups(u, a_re, a_im, log_dt, b_re, b_im, c_re, c_im, d_skip):
    f32 = jnp.float32
    lam = lax.complex(a_re.astype(f32), a_im.astype(f32))
    dt = jnp.exp(log_dt.astype(f32))[:, None]
    a_bar = jnp.exp(lam * dt)
    b = lax.complex(b_re.astype(f32), b_im.astype(f32))
    b_bar = ((a_bar - 1.0) / lam)[..., None] * b
    c = lax.complex(c_re.astype(f32), c_im.astype(f32))
    d = d_skip.astype(f32)

    def one_sequence(u_seq):
        uf = u_seq.astype(f32)
        bu = jnp.einsum('gph,lgh->lgp', b_bar, uf.astype(jnp.complex64))
        a_seq = jnp.broadcast_to(a_bar, bu.shape)
        _, states = lax.associative_scan(_ssm_binop, (a_seq, bu), axis=0)
        y = jnp.einsum('ghp,lgp->lgh', c, states).real + d * uf
        return y.astype(u_seq.dtype)

    return lax.map(one_sequence, u)


def setup_inputs(seed: int = 0) -> dict:
    key = jax.random.key(seed)
    ks = jax.random.split(key, 32)
    f32 = jnp.float32

    def nrm(k, shape, scale):
        return jax.random.normal(k, shape, f32) * scale

    def gain(k, shape):
        return 1.0 + 0.01 * jax.random.normal(k, shape, f32)

    L_, G, P, H = DEPTH, N_SSM_GROUPS, SSM_STATE, SSM_GROUP
    x = jax.random.normal(ks[0], (BATCH, SEQ, D_MODEL), f32)
    a_re = -0.5 + 0.01 * jax.random.normal(ks[1], (L_, G, P), f32)
    a_im = math.pi * jnp.arange(P, dtype=f32)[None, None, :] + 0.01 * jax.random.normal(ks[2], (L_, G, P), f32)
    log_dt = jax.random.uniform(ks[3], (L_, G), f32, math.log(DT_MIN), math.log(DT_MAX))
    return {
        "x": x,
        "w_in": nrm(ks[4], (L_, D_MODEL, IN_COLS), D_MODEL ** -0.5),
        "lambda_q1": nrm(ks[5], (L_, HEAD_DIM), 0.1),
        "lambda_k1": nrm(ks[6], (L_, HEAD_DIM), 0.1),
        "lambda_q2": nrm(ks[7], (L_, HEAD_DIM), 0.1),
        "lambda_k2": nrm(ks[8], (L_, HEAD_DIM), 0.1),
        "subln_w": gain(ks[9], (L_, 2 * HEAD_DIM)),
        "ssm_a_re": a_re,
        "ssm_a_im": a_im,
        "ssm_log_dt": log_dt,
        "ssm_b_re": nrm(ks[10], (L_, G, P, H), (2 * H) ** -0.5),
        "ssm_b_im": nrm(ks[11], (L_, G, P, H), (2 * H) ** -0.5),
        "ssm_c_re": nrm(ks[12], (L_, G, H, P), P ** -0.5),
        "ssm_c_im": nrm(ks[13], (L_, G, H, P), P ** -0.5),
        "ssm_d": nrm(ks[14], (L_, G, H), 1.0),
        "w_glu": nrm(ks[15], (L_, SSM_WIDTH, SSM_WIDTH), SSM_WIDTH ** -0.5),
        "b_glu": nrm(ks[16], (L_, SSM_WIDTH), 0.01),
        "w_attn_branch": nrm(ks[17], (L_, ATTN_WIDTH, D_MODEL), ATTN_WIDTH ** -0.5),
        "w_ssm_branch": nrm(ks[18], (L_, SSM_WIDTH, D_MODEL), SSM_WIDTH ** -0.5),
        "w_out": nrm(ks[19], (L_, D_MODEL, D_MODEL), D_MODEL ** -0.5),
        "norm_mix_pre": gain(ks[20], (L_, D_MODEL)),
        "norm_mix_post": gain(ks[21], (L_, D_MODEL)),
        "w_ffn_gate": nrm(ks[22], (L_, D_MODEL, D_FF), D_MODEL ** -0.5),
        "w_ffn_up": nrm(ks[23], (L_, D_MODEL, D_FF), D_MODEL ** -0.5),
        "w_ffn_down": nrm(ks[24], (L_, D_FF, D_MODEL), D_FF ** -0.5),
        "norm_ffn_pre": gain(ks[25], (L_, D_MODEL)),
        "norm_ffn_post": gain(ks[26], (L_, D_MODEL)),
    }


def reference(x, w_in, lambda_q1, lambda_k1, lambda_q2, lambda_k2, subln_w,
              ssm_a_re, ssm_a_im, ssm_log_dt, ssm_b_re, ssm_b_im, ssm_c_re, ssm_c_im,
              ssm_d, w_glu, b_glu, w_attn_branch, w_ssm_branch, w_out,
              norm_mix_pre, norm_mix_post, w_ffn_gate, w_ffn_up, w_ffn_down,
              norm_ffn_pre, norm_ffn_post):
    bsz, seq, _ = x.shape
    splits = np.cumsum([ATTN_WIDTH, ATTN_WIDTH, ATTN_WIDTH, SSM_WIDTH, D_MODEL]).tolist()
    h = x
    for l in range(DEPTH):
        lam_init = _lambda_init(l)
        u = _rms_norm(h, norm_mix_pre[l])
        proj = u @ w_in[l]
        q, k, v, s_in, g_a, g_s = jnp.split(proj, splits, axis=-1)
        q = q.reshape(bsz, seq, N_DIFF_HEADS, 2, HEAD_DIM)
        k = k.reshape(bsz, seq, N_DIFF_HEADS, 2, HEAD_DIM)
        v = v.reshape(bsz, seq, N_DIFF_HEADS, 2 * HEAD_DIM)
        f32 = jnp.float32
        lam = (jnp.exp(jnp.sum(lambda_q1[l].astype(f32) * lambda_k1[l].astype(f32)))
               - jnp.exp(jnp.sum(lambda_q2[l].astype(f32) * lambda_k2[l].astype(f32)))
               + lam_init)
        y_a = _diff_attention(q, k, v, lam, lam_init, subln_w[l])

        s_u = s_in.reshape(bsz, seq, N_SSM_GROUPS, SSM_GROUP)
        y_s = _s5_groups(s_u, ssm_a_re[l], ssm_a_im[l], ssm_log_dt[l], ssm_b_re[l],
                         ssm_b_im[l], ssm_c_re[l], ssm_c_im[l], ssm_d[l])
        y_s = jax.nn.gelu(y_s.reshape(bsz, seq, SSM_WIDTH))
        y_s = y_s * jax.nn.sigmoid(y_s @ w_glu[l] + b_glu[l])

        merged = (jax.nn.sigmoid(g_a) * (y_a @ w_attn_branch[l])
                  + jax.nn.sigmoid(g_s) * (y_s @ w_ssm_branch[l]))
        h = h + _rms_norm(merged @ w_out[l], norm_mix_post[l])
        z = _rms_norm(h, norm_ffn_pre[l])
        f = (jax.nn.silu(z @ w_ffn_gate[l]) * (z @ w_ffn_up[l])) @ w_ffn_down[l]
        h = h + _rms_norm(f, norm_ffn_post[l])
    return h
```

```cpp
#include <hip/hip_runtime.h>
#include <cstdio>
#include <cstdint>
constexpr size_t AWS_Q = 256ull << 20, AWS_K = 320ull << 20, AWS_V = 384ull << 20, AWS_OLO = 768ull << 20, AWS_OHI = 832ull << 20, AWS_YA = 128ull << 20, AWS_SW = 768 * 1024;
__device__ __forceinline__ int tid_now() { int t = threadIdx.x; asm volatile("" : "+v"(t)); return t; }
namespace pg8 {
#define PG8_LAS __attribute__((address_space(3)))
typedef unsigned short bf16_t;
typedef short bf16x8 __attribute__((ext_vector_type(8)));
typedef float f32x4 __attribute__((ext_vector_type(4)));
typedef unsigned u32x4 __attribute__((ext_vector_type(4)));
constexpr int BM = 256, BK = 64, HALF = 128, HTB = HALF * BK * 2  , STAGE_BYTES = 8 * HTB, NXCD = 8, WGM = 8;

__host__ __device__ __forceinline__ int lds_byte(int r, int c) { const int st = (r >> 4) * 2 + (c >> 5), rr = r & 15, cc = c & 31, ob = rr * 64 + cc * 2; return st * 1024 + (ob ^ (((ob >> 9) & 1) << 5)); }
__host__ __device__ __forceinline__ void stage_rc(int b, int& R, int& C) { const int st = b / 1024, sb = b % 1024, swz = sb ^ (((sb >> 9) & 1) << 5); R = (st >> 1) * 16 + swz / 64; C = (st & 1) * 32 + (swz % 64) / 2; }
__host__ __device__ __forceinline__ int perm32(int rho) { const int n = rho >> 4, i = rho & 15; return 8 * (i >> 2) + 4 * n + (i & 3); }

struct Unit { int pm, pn; };
struct Gemm { const bf16_t* A; const bf16_t* Bt; int M, N, K; int t8 = 0; };

struct StaticOrder {
    int nM, nN, nwg, G, c;
    __host__ __device__ void init(int M, int N, int G_, int c_) { nM = M / BM; nN = N / BM; nwg = nM * nN; G = G_; c = c_; }
    __host__ __device__ bool next(int i, Unit& u) const {
        const long L = (long)i * G + c; if (L >= nwg) return false;
        int wgid = (int)L; { const int q = nwg / NXCD, r = nwg % NXCD, xcd = wgid % NXCD, off = wgid / NXCD; wgid = (xcd < r ? xcd * (q + 1) : r * (q + 1) + (xcd - r) * q) + off; }
        const int nig = WGM * nN, gid = wgid / nig, fm = gid * WGM, gsz = (nM - fm) < WGM ? (nM - fm) : WGM;
        u.pm = fm + ((wgid % nig) % gsz); u.pn = (wgid % nig) / gsz; return true;
    }
    __device__ __forceinline__ void a_ready(const Unit&) const {}
    __device__ __forceinline__ void done(const Unit&) const {}
};

__device__ __forceinline__ unsigned cvt_pk_bf16(float lo, float hi) { unsigned r; asm volatile("v_cvt_pk_bf16_f32 %0, %1, %2" : "=v"(r) : "v"(lo), "v"(hi)); return r; }
typedef float f32x2 __attribute__((ext_vector_type(2)));
__device__ __forceinline__ f32x2 gelu_pk(f32x2 v) {
    const f32x2 av = __builtin_elementwise_abs(v), d = av * 0.2316418882f + 1.0f;
    f32x2 t; t.x = __builtin_amdgcn_rcpf(d.x); t.y = __builtin_amdgcn_rcpf(d.y);
    f32x2 q = t * 0.5307027145f + (-0.7265760135f); q = q * t + 0.7107068705f; q = q * t + (-0.142248368f); q = q * t + 0.127414796f; q = q * t;
    const f32x2 s = (v * v) * (-0.72134752044f);
    f32x2 e; e.x = __builtin_amdgcn_exp2f(s.x); e.y = __builtin_amdgcn_exp2f(s.y);
    const f32x2 m = v * (q * e), r = v - m;
    f32x2 o; o.x = v.x < 0.f ? m.x : r.x; o.y = v.y < 0.f ? m.y : r.y; return o;
}

template <int ACT  > struct EpiBf16 {
    static constexpr bool PERM = true, AFTER_DRAIN = false, MID_HOOK = false; static_assert(ACT == 0 || ACT == 1, "EpiBf16: ACT is 0 (none) or 1 (gelu_pk)");
    bf16_t* O; int ldc; const float* bias; int split_cols; size_t split_stride; float scale0;
    __device__ __forceinline__ void operator()(const f32x4 (&acc)[2][2][4][2], const Unit& u, int wr, int wc, int fr, int fq) const {
        const int row0 = u.pm * BM + wr * 64 + fr; int colt = u.pn * BM; bf16_t* base = O;
        float sc = 1.f; if (split_cols) { const int t = colt / split_cols; base += (size_t)t * split_stride; colt -= t * split_cols; if (t == 0) sc = scale0; }
        const int col0 = colt + wc * 32 + 8 * fq, bcol0 = u.pn * BM + wc * 32 + 8 * fq;
        f32x4 bv[2][2];
#pragma unroll
        for (int bj = 0; bj < 2; ++bj)
#pragma unroll
            for (int n = 0; n < 2; ++n) bv[bj][n] = bias ? *(const f32x4*)(bias + bcol0 + bj * HALF + 4 * n) : (f32x4){0.f, 0.f, 0.f, 0.f};
#pragma unroll
        for (int ai = 0; ai < 2; ++ai)
#pragma unroll
            for (int m = 0; m < 4; ++m) { bf16_t* rowp = base + (size_t)(row0 + ai * HALF + m * 16) * ldc + col0;
#pragma unroll
                for (int bj = 0; bj < 2; ++bj) { f32x4 v0 = acc[ai][bj][m][0] + bv[bj][0], v1 = acc[ai][bj][m][1] + bv[bj][1];
                    if (ACT == 1) { f32x2 a = gelu_pk((f32x2){v0[0], v0[1]}), b = gelu_pk((f32x2){v0[2], v0[3]}), c = gelu_pk((f32x2){v1[0], v1[1]}), d = gelu_pk((f32x2){v1[2], v1[3]});
                        v0 = (f32x4){a.x, a.y, b.x, b.y}; v1 = (f32x4){c.x, c.y, d.x, d.y}; }
                    v0 = v0 * sc; v1 = v1 * sc; u32x4 w; w.x = cvt_pk_bf16(v0[0], v0[1]); w.y = cvt_pk_bf16(v0[2], v0[3]); w.z = cvt_pk_bf16(v1[0], v1[1]); w.w = cvt_pk_bf16(v1[2], v1[3]);
                    *(u32x4*)(rowp + bj * HALF) = w; } }
    }
};


template <class Epi, class Sched, bool ALIGN_EPI = false, bool SP2 = false, bool FP8 = false, bool MIX8 = false>
__device__ __forceinline__ void gemm_phase(PG8_LAS unsigned char* lds, const Gemm g, const Sched& S, const Epi& E) {
    const int tid = tid_now(), wid = __builtin_amdgcn_readfirstlane(tid >> 6), lane = tid & 63, wr = wid >> 2, wc = wid & 3, fr = lane & 15, fq = lane >> 4;
    const int K = g.K, nt = K / BK;
    unsigned voffA[2], voffB[2];
#pragma unroll
    for (int i = 0; i < 2; ++i) { int R, C; stage_rc(tid * 16 + i * 8192, R, C); const int Rb = Epi::PERM ? ((R & ~31) + perm32(R & 31)) : R;
        voffA[i] = (unsigned)(R * K + C) * 2u; voffB[i] = (unsigned)(Rb * K + C) * 2u; }
    const size_t kstep = (size_t)(BK * 2);
    const size_t hstep = (size_t)HALF * K * 2;
    const size_t tstep = 2 * hstep;
    const unsigned ldsw = (unsigned)wid * 1024u;
    const int aoff = lds_byte(wr * 64 + fr, fq * 8), boff = lds_byte(wc * 32 + fr, fq * 8);
#define PG8_SA(b, h) (((b) * 2 + (h)) * HTB)
#define PG8_SB(b, h) ((4 + (b) * 2 + (h)) * HTB)
#define PG8_STAGE(bufoff, gbase, voff) do { _Pragma("unroll") for (int _i = 0; _i < 2; ++_i) \
        __builtin_amdgcn_global_load_lds((const unsigned*)((const char*)(gbase) + (voff)[_i]), (PG8_LAS unsigned*)(lds + (bufoff) + ldsw + _i * 8192), 16, 0, 0); } while (0)
#define PG8_LDA(dst, b, h) do { _Pragma("unroll") for (int m = 0; m < 4; ++m) _Pragma("unroll") for (int k = 0; k < 2; ++k) dst[m][k] = *(const PG8_LAS bf16x8*)(lds + PG8_SA(b, h) + aoff + m * 2048 + k * 1024); } while (0)
#define PG8_LDB(dst, b, h) do { _Pragma("unroll") for (int n = 0; n < 2; ++n) _Pragma("unroll") for (int k = 0; k < 2; ++k) dst[n][k] = *(const PG8_LAS bf16x8*)(lds + PG8_SB(b, h) + boff + n * 2048 + k * 1024); } while (0)
#define PG8_MMA_F8(ai, bj, At, Bt) do { __builtin_amdgcn_s_setprio(1); { typedef int v4i_ __attribute__((ext_vector_type(4))); typedef int v8i_ __attribute__((ext_vector_type(8))); \
            _Pragma("unroll") for (int m = 0; m < 4; ++m) _Pragma("unroll") for (int n = 0; n < 2; ++n) \
                { const v8i_ b8_ = __builtin_shufflevector(__builtin_bit_cast(v4i_, Bt[n][0]), __builtin_bit_cast(v4i_, Bt[n][1]), 0, 1, 2, 3, 4, 5, 6, 7), \
                             a8_ = __builtin_shufflevector(__builtin_bit_cast(v4i_, At[m][0]), __builtin_bit_cast(v4i_, At[m][1]), 0, 1, 2, 3, 4, 5, 6, 7); \
                  asm volatile("v_mfma_scale_f32_16x16x128_f8f6f4 %0, %1, %2, %0, %3, %3 op_sel_hi:[0,0,0]" : "+v"(acc[ai][bj][m][n]) : "v"(b8_), "v"(a8_), "v"(0x7f7f7f7f)); }     \
        } __builtin_amdgcn_s_setprio(0); } while (0)
#define PG8_MMA_BF(ai, bj, At, Bt) do { __builtin_amdgcn_s_setprio(1); _Pragma("unroll") for (int m = 0; m < 4; ++m) _Pragma("unroll") for (int n = 0; n < 2; ++n) _Pragma("unroll") for (int k = 0; k < 2; ++k) \
        acc[ai][bj][m][n] = __builtin_amdgcn_mfma_f32_16x16x32_bf16(Bt[n][k], At[m][k], acc[ai][bj][m][n], 0, 0, 0); __builtin_amdgcn_s_setprio(0); } while (0)
#define PG8_MMA_BFA(ai, bj, At, Bt) do { __builtin_amdgcn_s_setprio(1); _Pragma("unroll") for (int k = 0; k < 2; ++k) _Pragma("unroll") for (int m = 0; m < 4; ++m) _Pragma("unroll") for (int n = 0; n < 2; ++n) \
        asm volatile("v_mfma_f32_16x16x32_bf16 %0, %1, %2, %0" : "+v"(acc[ai][bj][m][n]) : "v"(Bt[n][k]), "v"(At[m][k])); __builtin_amdgcn_s_setprio(0); } while (0)
#define PG8_MMA(ai, bj, At, Bt) do { if constexpr (FP8) PG8_MMA_F8(ai, bj, At, Bt); else PG8_MMA_BF(ai, bj, At, Bt); } while (0)
#define PG8_SP2_BODY(MM) do { \
            PG8_LDB(B0, 0, 0); PG8_LDB(B1, 0, 1); PG8_SCHED; PG8_LDA(At, 0, 0); PG8_STAGE(PG8_SA(1, 1), a1 + hstep, voffA); \
            PG8_WAIT_V(8); PG8_WAIT_L(0); PG8_BAR; MM(0, 0, At, B0); MM(0, 1, At, B1); PG8_BAR; PG8_SCHED; \
            PG8_LDA(At, 0, 1); PG8_STAGE(PG8_SB(0, 0), b2, voffB); PG8_STAGE(PG8_SB(0, 1), b2 + hstep, voffB); PG8_STAGE(PG8_SA(0, 0), a2, voffA); \
            PG8_WAIT_V(8); PG8_WAIT_L(0); PG8_BAR; MM(1, 0, At, B0); MM(1, 1, At, B1); PG8_BAR; PG8_SCHED; \
            PG8_LDB(B0, 1, 0); PG8_LDB(B1, 1, 1); PG8_SCHED; PG8_LDA(At, 1, 0); PG8_STAGE(PG8_SA(0, 1), a2 + hstep, voffA); \
            PG8_WAIT_V(8); PG8_WAIT_L(0); PG8_BAR; MM(0, 0, At, B0); MM(0, 1, At, B1); PG8_BAR; PG8_SCHED; \
            PG8_LDA(At, 1, 1); PG8_STAGE(PG8_SB(1, 0), b3, voffB); PG8_STAGE(PG8_SB(1, 1), b3 + hstep, voffB); PG8_STAGE(PG8_SA(1, 0), a3, voffA); \
            PG8_WAIT_V(8); PG8_WAIT_L(0); PG8_BAR; MM(1, 0, At, B0); MM(1, 1, At, B1); PG8_BAR; PG8_SCHED; \
            } while (0)
#define PG8_WAIT_V(n) asm volatile("s_waitcnt vmcnt(" #n ")" ::: "memory")
#define PG8_WAIT_L(n) asm volatile("s_waitcnt lgkmcnt(" #n ")" ::: "memory")
#define PG8_BAR __builtin_amdgcn_s_barrier()
#define PG8_SCHED __builtin_amdgcn_sched_barrier(0)
    Unit cur, nxt; int ui = 0;
    if (!S.next(0, cur)) return;
    f32x4 acc[2][2][4][2];
#pragma unroll
    for (int a = 0; a < 2; ++a)
#pragma unroll
        for (int b = 0; b < 2; ++b)
#pragma unroll
            for (int m = 0; m < 4; ++m)
#pragma unroll
                for (int n = 0; n < 2; ++n) acc[a][b][m][n] = (f32x4){0.f, 0.f, 0.f, 0.f};
    bf16x8 At[4][2], B0[2][2], B1[2][2];
    const char* cA = (const char*)g.A + (size_t)cur.pm * tstep; const char* cB = (const char*)g.Bt + (size_t)cur.pn * tstep;
    S.a_ready(cur);
    if constexpr (SP2) {
        PG8_STAGE(PG8_SB(0, 0), cB, voffB); PG8_STAGE(PG8_SB(0, 1), cB + hstep, voffB); PG8_STAGE(PG8_SA(0, 0), cA, voffA); PG8_STAGE(PG8_SA(0, 1), cA + hstep, voffA);
        if (wr == 1) PG8_BAR;
        PG8_WAIT_V(2); PG8_BAR;
        PG8_STAGE(PG8_SB(1, 0), cB + kstep, voffB); PG8_STAGE(PG8_SA(1, 0), cA + kstep, voffA); PG8_STAGE(PG8_SB(1, 1), cB + hstep + kstep, voffB);
        PG8_WAIT_V(6); PG8_BAR;
    } else {
        PG8_STAGE(PG8_SB(0, 0), cB, voffB); PG8_STAGE(PG8_SA(0, 0), cA, voffA); PG8_STAGE(PG8_SB(0, 1), cB + hstep, voffB); PG8_STAGE(PG8_SA(0, 1), cA + hstep, voffA);
        if (wr == 1) PG8_BAR;
        PG8_WAIT_V(4); PG8_BAR;
        PG8_STAGE(PG8_SB(1, 0), cB + kstep, voffB); PG8_STAGE(PG8_SA(1, 0), cA + kstep, voffA); PG8_STAGE(PG8_SB(1, 1), cB + hstep + kstep, voffB);
        PG8_WAIT_V(6); PG8_BAR;
    }
    for (;;) {
        const bool has_next = S.next(ui + 1, nxt);
        const char* nA = has_next ? (const char*)g.A + (size_t)nxt.pm * tstep : cA; const char* nB = has_next ? (const char*)g.Bt + (size_t)nxt.pn * tstep : cB;
#define PG8_TRIP(MM) { const bool last = (t == nt - 2); const char* a1 = cA + (size_t)(t + 1) * kstep; \
            const char* a2 = last ? nA : cA + (size_t)(t + 2) * kstep; const char* b2 = last ? nB : cB + (size_t)(t + 2) * kstep; const char* a3 = a2 + kstep; const char* b3 = b2 + kstep; \
            if (last && has_next) S.a_ready(nxt); PG8_SP2_BODY(MM); }
        if constexpr (MIX8) {
            static_assert(SP2 && Epi::MID_HOOK, "MIX8 is written for the SP2 loop with a mid-K hook");
            int t = 0;
            for (; t < g.t8; t += 2) PG8_TRIP(PG8_MMA_F8)
            asm volatile("s_nop 15\n\ts_nop 15\n\ts_nop 15" ::: "memory");
            E.mid(acc, cur, wr, wc, fr, fq);
            for (; t < nt; t += 2) PG8_TRIP(PG8_MMA_BF)
        } else
        for (int t = 0; t < nt; t += 2) {
            const bool last = (t == nt - 2);
            if constexpr (Epi::MID_HOOK) { if (t == E.mid_t(nt)) { if constexpr (FP8) asm volatile("s_nop 15\n\ts_nop 15\n\ts_nop 15" ::: "memory");
                E.mid(acc, cur, wr, wc, fr, fq); } }
            const char* a1 = cA + (size_t)(t + 1) * kstep;
            const char* a2 = last ? nA : cA + (size_t)(t + 2) * kstep; const char* b2 = last ? nB : cB + (size_t)(t + 2) * kstep;
            const char* a3 = a2 + kstep; const char* b3 = b2 + kstep;
            if (last && has_next) S.a_ready(nxt);
            if constexpr (SP2) {
            if constexpr (FP8) PG8_SP2_BODY(PG8_MMA_F8); else PG8_SP2_BODY(PG8_MMA_BF);
            } else {
            PG8_LDB(B0, 0, 0); PG8_SCHED; PG8_LDA(At, 0, 0); PG8_STAGE(PG8_SA(1, 1), a1 + hstep, voffA);
            PG8_WAIT_L(8); PG8_BAR; PG8_WAIT_L(0); PG8_MMA(0, 0, At, B0); PG8_BAR; PG8_SCHED;
            PG8_LDB(B1, 0, 1); PG8_STAGE(PG8_SB(0, 0), b2, voffB);
            PG8_BAR; PG8_WAIT_L(0); PG8_MMA(0, 1, At, B1); PG8_BAR;
            PG8_LDA(At, 0, 1); PG8_STAGE(PG8_SA(0, 0), a2, voffA);
            PG8_BAR; PG8_WAIT_L(0); PG8_MMA(1, 0, At, B0); PG8_BAR; PG8_SCHED;
            PG8_STAGE(PG8_SB(0, 1), b2 + hstep, voffB);
            PG8_WAIT_V(6); PG8_BAR; PG8_MMA(1, 1, At, B1); PG8_BAR;
            PG8_LDB(B0, 1, 0); PG8_SCHED; PG8_LDA(At, 1, 0); PG8_STAGE(PG8_SA(0, 1), a2 + hstep, voffA);
            PG8_WAIT_L(8); PG8_BAR; PG8_WAIT_L(0); PG8_MMA(0, 0, At, B0); PG8_BAR; PG8_SCHED;
            PG8_LDB(B1, 1, 1); PG8_STAGE(PG8_SB(1, 0), b3, voffB);
            PG8_BAR; PG8_WAIT_L(0); PG8_MMA(0, 1, At, B1); PG8_BAR;
            PG8_LDA(At, 1, 1); PG8_STAGE(PG8_SA(1, 0), a3, voffA);
            PG8_BAR; PG8_WAIT_L(0); PG8_MMA(1, 0, At, B0); PG8_BAR; PG8_SCHED;
            PG8_STAGE(PG8_SB(1, 1), b3 + hstep, voffB);
            PG8_WAIT_V(6); PG8_BAR; PG8_MMA(1, 1, At, B1); PG8_BAR;
            }
        }
        if constexpr (FP8 || MIX8) asm volatile("s_nop 15\n\ts_nop 15" ::: "memory");
        if constexpr (ALIGN_EPI) { if (wr == 0) PG8_BAR; }
        if constexpr (!Epi::AFTER_DRAIN) { E(acc, cur, wr, wc, fr, fq); S.done(cur); }
        if (!has_next) break;
#pragma unroll
        for (int a = 0; a < 2; ++a)
#pragma unroll
            for (int b = 0; b < 2; ++b)
#pragma unroll
                for (int m = 0; m < 4; ++m)
#pragma unroll
                    for (int n = 0; n < 2; ++n) acc[a][b][m][n] = (f32x4){0.f, 0.f, 0.f, 0.f};
        cur = nxt; cA = nA; cB = nB; ++ui;
        if constexpr (ALIGN_EPI) { if (wr == 1) PG8_BAR; }
    }
    PG8_WAIT_V(0);
    if constexpr (!ALIGN_EPI) { if (wr == 0) PG8_BAR; }
    PG8_BAR;
    if constexpr (Epi::AFTER_DRAIN) { E.fused(acc, cur, wr, wc, fr, fq, lds, wid, lane); S.done(cur); }
#undef PG8_SA
#undef PG8_SB
#undef PG8_STAGE
#undef PG8_LDA
#undef PG8_LDB
#undef PG8_MMA
#undef PG8_MMA_F8
#undef PG8_MMA_BF
#undef PG8_MMA_BFA
#undef PG8_TRIP
#undef PG8_SP2_BODY
#undef PG8_WAIT_V
#undef PG8_WAIT_L
#undef PG8_BAR
#undef PG8_SCHED
}
}

#ifndef PG8_SP2
#define PG8_SP2 true
#endif
#ifndef PG8_ALIGN
#define PG8_ALIGN true
#endif
#include <hip/hip_bf16.h>
#include <cmath>
namespace attn_body {
using bf16=__hip_bfloat16;
using bf16x8=__attribute__((ext_vector_type(8)))short;
using s16x4=__attribute__((ext_vector_type(4)))short;
using f32x16=__attribute__((ext_vector_type(16)))float;
using u32x4=__attribute__((ext_vector_type(4)))unsigned;
constexpr int BATCH=4,NHEAD=16,SEQ=8192,D=64,DM=NHEAD*D;
constexpr int NW=8,QBLK=32,QB=QBLK*NW,KVBLK=64,NQB=SEQ/QB;
constexpr int ATTN_PITCH=DM, ATTN_UNIT_ROWS=QB;
__device__ __forceinline__ int crow(int r,int hi){return (r&3)+8*(r>>2)+4*hi;}
#define SBAR() __builtin_amdgcn_sched_barrier(0)
__device__ __forceinline__ void cmask(f32x16&p0,f32x16&p1,int jb,int qrel,int hi){
  const float NEG=-INFINITY; int kb=64*jb+4*hi;
  #pragma unroll
  for(int r=0;r<16;++r){int kv=kb+(r&3)+8*(r>>2); if(kv>qrel)p0[r]=NEG; if(kv+32>qrel)p1[r]=NEG;}
}

constexpr int NSLOT=3, SLOTB=8192;
constexpr int LDS_K=0, LDS_V=NSLOT*SLOTB, LDS_V2=2*NSLOT*SLOTB, LDS_WS=3*NSLOT*SLOTB, LDS_OST=LDS_WS+NW*64*4, LDS_BYTES=LDS_OST+NW*4096;
constexpr float C2=0.125f*1.4426950408889634f;
__device__ __forceinline__ void glds16(const void*gsrc,unsigned lds_dst){unsigned keep;
  asm volatile("s_mov_b32 %0, m0\n\ts_mov_b32 m0, %2\n\ts_nop 0\n\tglobal_load_lds_dwordx4 %1, off\n\ts_mov_b32 m0, %0":"=&s"(keep):"v"(gsrc),"s"(lds_dst):"memory");}
__device__ __forceinline__ float max3f(float a,float b,float c){float r;asm("v_max3_f32 %0, %1, %2, %3":"=v"(r):"v"(a),"v"(b),"v"(c));return r;}
__device__ __forceinline__ float max2f(float a,float b){float r;asm("v_max_f32_e32 %0, %1, %2":"=v"(r):"v"(a),"v"(b));return r;}
__device__ __forceinline__ float fadd_s(float a,float b){float r;asm("v_add_f32_e32 %0, %1, %2":"=v"(r):"v"(a),"v"(b));return r;}
__device__ __forceinline__ float fsub_s(float a,float b){float r;asm("v_sub_f32_e32 %0, %1, %2":"=v"(r):"v"(a),"v"(b));return r;}
typedef float f32x2_t __attribute__((ext_vector_type(2))); typedef __bf16 bf16x2_t __attribute__((ext_vector_type(2)));
__device__ __forceinline__ unsigned cvtpk_s(float lo,float hi){f32x2_t v={lo,hi};bf16x2_t b=__builtin_convertvector(v,bf16x2_t);return __builtin_bit_cast(unsigned,b);}
#define WAIT_BAR(N) asm volatile("s_waitcnt vmcnt(" #N ") lgkmcnt(0)\n\ts_barrier":::"memory")

__device__ __forceinline__ void qkt(f32x16&p0,f32x16&p1,const char*Kslot,const bf16x8*qr,const f32x16&negm,int r32,int hi){
  const char*kb=Kslot+hi*1024+r32*16;
  #pragma unroll
  for(int d0=0;d0<4;++d0){
    const bf16x8 b0=*reinterpret_cast<const bf16x8*>(kb+d0*2048);
    const bf16x8 b1=*reinterpret_cast<const bf16x8*>(kb+d0*2048+512);
    if(d0==0){p0=__builtin_amdgcn_mfma_f32_32x32x16_bf16(b0,qr[0],negm,0,0,0);p1=__builtin_amdgcn_mfma_f32_32x32x16_bf16(b1,qr[0],negm,0,0,0);}
    else{p0=__builtin_amdgcn_mfma_f32_32x32x16_bf16(b0,qr[d0],p0,0,0,0);p1=__builtin_amdgcn_mfma_f32_32x32x16_bf16(b1,qr[d0],p1,0,0,0);}}
}
typedef __attribute__((address_space(3))) const char* lds_cptr;
typedef short v4i16_t __attribute__((ext_vector_type(4)));
__device__ __forceinline__ void kload8(bf16x8*kf,lds_cptr kp){
  kf[0]=*(const __attribute__((address_space(3))) bf16x8*)(kp);      kf[1]=*(const __attribute__((address_space(3))) bf16x8*)(kp+512);
  kf[2]=*(const __attribute__((address_space(3))) bf16x8*)(kp+2048); kf[3]=*(const __attribute__((address_space(3))) bf16x8*)(kp+2560);
  kf[4]=*(const __attribute__((address_space(3))) bf16x8*)(kp+4096); kf[5]=*(const __attribute__((address_space(3))) bf16x8*)(kp+4608);
  kf[6]=*(const __attribute__((address_space(3))) bf16x8*)(kp+6144); kf[7]=*(const __attribute__((address_space(3))) bf16x8*)(kp+6656);
}
__device__ __forceinline__ void kload2(bf16x8*kf,lds_cptr kp,int j){ kf[2*j]=*(const __attribute__((address_space(3))) bf16x8*)(kp+j*2048); kf[2*j+1]=*(const __attribute__((address_space(3))) bf16x8*)(kp+j*2048+512); }
__device__ __forceinline__ s16x4 vtr(lds_cptr p){ return __builtin_bit_cast(s16x4,__builtin_amdgcn_ds_read_tr16_b64_v4i16((__attribute__((address_space(3))) v4i16_t*)p)); }
__device__ __forceinline__ float rowmax(const f32x16&p0,const f32x16&p1){
  float a=max3f(p0[0],p0[1],p1[0]),b=max3f(p0[2],p0[3],p1[1]);a=max3f(a,p1[2],p1[3]);
  #pragma unroll
  for(int r=4;r<16;r+=4){a=max3f(a,p0[r],p0[r+1]);b=max3f(b,p0[r+2],p0[r+3]);a=max3f(a,p1[r],p1[r+1]);b=max3f(b,p1[r+2],p1[r+3]);}
  const float m=max2f(a,b);
  auto rr=__builtin_amdgcn_permlane32_swap(__float_as_uint(m),__float_as_uint(m),false,false);
  return max2f(__uint_as_float(rr[0]),__uint_as_float(rr[1]));
}
__device__ __forceinline__ void pv(f32x16*o,int vb,bf16x8 pa0,bf16x8 pa1,bf16x8 pa2,bf16x8 pa3){
  #pragma unroll
  for(int d0=0;d0<2;++d0){s16x4 lo[4],hi[4];
    #pragma unroll
    for(int ks=0;ks<4;++ks){
      asm volatile("ds_read_b64_tr_b16 %0,%1 offset:%c2":"=&v"(lo[ks]):"v"(vb),"i"(d0*4096+ks*1024):"memory");
      asm volatile("ds_read_b64_tr_b16 %0,%1 offset:%c2":"=&v"(hi[ks]):"v"(vb),"i"(d0*4096+ks*1024+512):"memory");}
    asm volatile("s_waitcnt lgkmcnt(0)":::"memory");SBAR();
    #define PK(k) (bf16x8){lo[k][0],lo[k][1],lo[k][2],lo[k][3],hi[k][0],hi[k][1],hi[k][2],hi[k][3]}
    o[d0]=__builtin_amdgcn_mfma_f32_32x32x16_bf16(pa0,PK(0),o[d0],0,0,0);
    o[d0]=__builtin_amdgcn_mfma_f32_32x32x16_bf16(pa1,PK(1),o[d0],0,0,0);
    o[d0]=__builtin_amdgcn_mfma_f32_32x32x16_bf16(pa2,PK(2),o[d0],0,0,0);
    o[d0]=__builtin_amdgcn_mfma_f32_32x32x16_bf16(pa3,PK(3),o[d0],0,0,0);
    #undef PK
  }
}

#ifndef ATTN_STORE16
#define ATTN_STORE16(p,v) (*(u32x4*)(p)=(v))
#endif
template<int THRL> __device__ __forceinline__ void attn_unit(int b,int h,int qb,unsigned char*wsb,char*shm,float kmax,const int CMB,float lam){
  const bf16*Q,*K,*V; { unsigned char*w_=wsb; asm volatile("":"+s"(w_)); Q=(const bf16*)(w_+AWS_Q); K=(const bf16*)(w_+AWS_K); V=(const bf16*)(w_+AWS_V); }
  constexpr int ya_pitch=2048;
  const int tid=tid_now(),lane=tid&63,r32=lane&31,hi=lane>>5; const int wid=__builtin_amdgcn_readfirstlane(tid>>6);
  const long rowbase=(long)b*SEQ; const int q0=qb*QB;
  const bf16*Qw=Q+(rowbase+q0+wid*QBLK)*DM+h*D;
  const bf16*Kh=K+rowbase*DM+h*D,*Vh=V+rowbase*DM+(h&~1)*D;
  const unsigned lds0=(unsigned)(uintptr_t)shm;
  float*wsf=(float*)(shm+LDS_WS)+wid*64;
  const bf16*ksrc=Kh+(long)lane*DM+wid*8;
  const bf16*vsrc=Vh+(long)(16*(wid&3)+(lane>>2))*DM+(wid>>2)*32+(lane&3)*8;
  const unsigned kdst=lds0+LDS_K+wid*1024, vdst=lds0+LDS_V+wid*1024, vdst2=lds0+LDS_V2+wid*1024;
  #define DMA_K(t,slot) glds16(ksrc+(long)(t)*KVBLK*DM,(unsigned)__builtin_amdgcn_readfirstlane(kdst+(slot)))
  #define DMA_V(t,slot) do{ glds16(vsrc+(long)(t)*KVBLK*DM,(unsigned)__builtin_amdgcn_readfirstlane(vdst+(slot))); glds16(vsrc+64+(long)(t)*KVBLK*DM,(unsigned)__builtin_amdgcn_readfirstlane(vdst2+(slot))); }while(0)
  const int vb0=(int)(lds0+LDS_V)+((lane>>4)&1)*32+(lane&3)*8+(4*hi+((lane&15)>>2))*64;
  const char*Kbase=shm+LDS_K; bf16x8 kf[8];
  const lds_cptr shm3=(lds_cptr)shm; const lds_cptr kp0=shm3+LDS_K+hi*1024+r32*16; const lds_cptr vp0=shm3+LDS_V+((lane>>4)&1)*32+(lane&3)*8+(4*hi+((lane&15)>>2))*64;
  const int NT=(q0+QB)/KVBLK;
  DMA_K(0,0);DMA_V(0,0);DMA_K(1,SLOTB);
  bf16x8 qr[4];
  #pragma unroll
  for(int d0=0;d0<4;++d0)qr[d0]=*reinterpret_cast<const bf16x8*>(&Qw[(long)r32*DM+d0*16+hi*8]);
  float q2_=0.f;
  #pragma unroll
  for(int d0=0;d0<4;++d0){const u32x4 w_=__builtin_bit_cast(u32x4,qr[d0]);
    #pragma unroll
    for(int e=0;e<4;++e){const float lo_=__uint_as_float(w_[e]<<16),hi_=__uint_as_float(w_[e]&0xffff0000u);q2_+=lo_*lo_+hi_*hi_;}}
  {auto rr=__builtin_amdgcn_permlane32_swap(__float_as_uint(q2_),__float_as_uint(q2_),false,false);q2_=__uint_as_float(rr[0])+__uint_as_float(rr[1]);}
  const float mhat=sqrtf(q2_)*kmax*1.004f+0.02f;
  float l_reg=0.f;f32x16 o[2];o[0]=f32x16{};o[1]=f32x16{};f32x16 o2[2];o2[0]=f32x16{};o2[1]=f32x16{};const f32x16 negm=f32x16{};
  const int qrel=wid*QBLK+r32;
  #define CMASK(P0,P1,t) do{int jb_=(t)-(NT-4); if(jb_>=0)cmask(P0,P1,jb_,qrel,hi);}while(0)
  bool resc=false;
  #define START(P0,P1) do{ resc=false; \
    { _Pragma("unroll") for(int r=0;r<16;++r){P0[r]=fsub_s(P0[r],mhat);P1[r]=fsub_s(P1[r],mhat);} \
      } \
    _Pragma("unroll") for(int r=0;r<16;++r)P0[r]=__builtin_amdgcn_exp2f(P0[r]); }while(0)
  #define RESC() do{ if(resc){ asm volatile("s_waitcnt lgkmcnt(0)":::"memory"); \
      _Pragma("unroll") for(int d_=0;d_<2;++d_) _Pragma("unroll") for(int r=0;r<16;++r){const float f_=wsf[crow(r,hi)];o[d_][r]*=f_;o2[d_][r]*=f_;} } }while(0)
  f32x16 pA0,pA1,pB0,pB1;
  int sl_prev=0,sl_cur=0,sl_next=SLOTB;
  #define ROT() do{sl_prev=sl_cur;sl_cur=sl_next;sl_next=(sl_next==(NSLOT-1)*SLOTB)?0:sl_next+SLOTB;}while(0)
  DMA_K(2,2*SLOTB);
  WAIT_BAR(4);
  qkt(pA0,pA1,Kbase,qr,negm,r32,hi);asm volatile("s_nop 15\n\ts_nop 7":"+v"(pA0),"+v"(pA1));CMASK(pA0,pA1,0);
  START(pA0,pA1);
  _Pragma("unroll") for(int r=0;r<16;++r)pA1[r]=__builtin_amdgcn_exp2f(pA1[r]);
  WAIT_BAR(0);
  DMA_K(3,0);DMA_V(1,SLOTB);
  ROT();
  kload8(kf,kp0+sl_cur);
  WAIT_BAR(3);
  s16x4 vlo[8],vhi[8],v2lo[8],v2hi[8]; u32x4 pw0,pw1,pw2,pw3;
  #define PKW(P,B) cvtpk_s(P[B],P[B+1])
  #define PAF(k) __builtin_bit_cast(bf16x8,pw##k)
  #define VFR(i) (bf16x8){vlo[i][0],vlo[i][1],vlo[i][2],vlo[i][3],vhi[i][0],vhi[i][1],vhi[i][2],vhi[i][3]}
  #define PIN(x) asm volatile("":"+v"(x))
  #define MX3(a,b,c) __builtin_fmaxf(__builtin_fmaxf((a),(b)),(c))
  #define GAPA(MF,A0,A1,A2,A3,W0,W1,PW) do{ MF; sacc+=A0; sacc+=A1; sacc+=A2; sacc+=A3; PIN(sacc); W0; W1; PIN(PW); SBAR(); }while(0)
  #define EX(v) __builtin_amdgcn_exp2f(v)
  #define GAPB(MF,X,B) do{ MF; X[B]=EX(X[B]-mhat); X[B+1]=EX(X[B+1]-mhat); X[B+2]=EX(X[B+2]-mhat); X[B+3]=EX(X[B+3]-mhat); PIN(X); SBAR(); }while(0)
  #define GAPB2(MF,X,B) do{ MF; X[B]=EX(X[B]-mhat); X[B+1]=EX(X[B+1]-mhat); PIN(X); SBAR(); }while(0)
  #define VRD2(i) do{ v2lo[i]=vtr(vp2_+(((i)>>2)*4096+((i)&3)*1024)); v2hi[i]=vtr(vp2_+(((i)>>2)*4096+((i)&3)*1024+512)); }while(0)
  #define V2FR(i) (bf16x8){v2lo[i][0],v2lo[i][1],v2lo[i][2],v2lo[i][3],v2hi[i][0],v2hi[i][1],v2hi[i][2],v2hi[i][3]}
  #define VRD(i) do{ vlo[i]=vtr(vp_+(((i)>>2)*4096+((i)&3)*1024)); vhi[i]=vtr(vp_+(((i)>>2)*4096+((i)&3)*1024+512)); }while(0)
  #define KRD(G,j) do{ if(G){ kload2(kf,kp0+sl_next,j); SBAR(); } }while(0)
  #define STEP(C0,C1,P0,P1,t,GK,GV,GL) do{ SBAR(); \
    const lds_cptr vp_=vp0+sl_prev; \
    VRD(0); SBAR(); float sacc=(P0[0]+P0[1]); \
    GAPA(C0=__builtin_amdgcn_mfma_f32_32x32x16_bf16(kf[0],qr[0],negm,0,0,0), P0[2],P0[3],P0[4],P0[5],     pw0[0]=PKW(P0,0), pw0[1]=PKW(P0,2), pw0); \
    VRD(4); SBAR(); GAPA(C1=__builtin_amdgcn_mfma_f32_32x32x16_bf16(kf[1],qr[0],negm,0,0,0), P0[6],P0[7],P0[8],P0[9],     pw0[2]=PKW(P0,4), pw0[3]=PKW(P0,6), pw0); \
    VRD(1); SBAR(); GAPA(C0=__builtin_amdgcn_mfma_f32_32x32x16_bf16(kf[2],qr[1],C0,0,0,0),   P0[10],P0[11],P0[12],P0[13], pw1[0]=PKW(P0,8), pw1[1]=PKW(P0,10), pw1); \
    VRD(5); SBAR(); GAPA(C1=__builtin_amdgcn_mfma_f32_32x32x16_bf16(kf[3],qr[1],C1,0,0,0),   P0[14],P0[15],P1[0],P1[1],   pw1[2]=PKW(P0,12),pw1[3]=PKW(P0,14), pw1); \
    VRD(2); SBAR(); GAPA(C0=__builtin_amdgcn_mfma_f32_32x32x16_bf16(kf[4],qr[2],C0,0,0,0),   P1[2],P1[3],P1[4],P1[5],     pw2[0]=PKW(P1,0), pw2[1]=PKW(P1,2), pw2); \
    VRD(6); SBAR(); GAPA(C1=__builtin_amdgcn_mfma_f32_32x32x16_bf16(kf[5],qr[2],C1,0,0,0),   P1[6],P1[7],P1[8],P1[9],     pw2[2]=PKW(P1,4), pw2[3]=PKW(P1,6), pw2); \
    VRD(3); SBAR(); GAPA(C0=__builtin_amdgcn_mfma_f32_32x32x16_bf16(kf[6],qr[3],C0,0,0,0),   P1[10],P1[11],P1[12],P1[13], pw3[0]=PKW(P1,8), pw3[1]=PKW(P1,10), pw3); \
    VRD(7); SBAR(); GAPA(C1=__builtin_amdgcn_mfma_f32_32x32x16_bf16(kf[7],qr[3],C1,0,0,0),   P1[14],P1[15],0.f,0.f,       pw3[2]=PKW(P1,12),pw3[3]=PKW(P1,14), pw3); \
    l_reg+=sacc; \
    if(GK){DMA_K((t)+3,sl_cur);} if(GV){DMA_V((t)+1,sl_next);} \
    CMASK(C0,C1,t); \
    SBAR(); \
    const lds_cptr vp2_=vp0+(LDS_V2-LDS_V)+sl_prev; \
    GAPB2(o[0]=__builtin_amdgcn_mfma_f32_32x32x16_bf16(PAF(0),VFR(0),o[0],0,0,0), C0,0); VRD2(0); SBAR(); \
    GAPB2(o[1]=__builtin_amdgcn_mfma_f32_32x32x16_bf16(PAF(0),VFR(4),o[1],0,0,0), C0,2); VRD2(4); SBAR(); \
    KRD(GL,0); GAPB2(o[0]=__builtin_amdgcn_mfma_f32_32x32x16_bf16(PAF(1),VFR(1),o[0],0,0,0), C0,4); VRD2(1); SBAR(); \
    KRD(GL,1); GAPB2(o[1]=__builtin_amdgcn_mfma_f32_32x32x16_bf16(PAF(1),VFR(5),o[1],0,0,0), C0,6); VRD2(5); SBAR(); \
    KRD(GL,2); GAPB2(o[0]=__builtin_amdgcn_mfma_f32_32x32x16_bf16(PAF(2),VFR(2),o[0],0,0,0), C0,8); VRD2(2); SBAR(); \
    KRD(GL,3); GAPB2(o[1]=__builtin_amdgcn_mfma_f32_32x32x16_bf16(PAF(2),VFR(6),o[1],0,0,0), C0,10); VRD2(6); SBAR(); \
    GAPB2(o[0]=__builtin_amdgcn_mfma_f32_32x32x16_bf16(PAF(3),VFR(3),o[0],0,0,0), C0,12); VRD2(3); SBAR(); \
    GAPB2(o[1]=__builtin_amdgcn_mfma_f32_32x32x16_bf16(PAF(3),VFR(7),o[1],0,0,0), C0,14); VRD2(7); SBAR(); \
    GAPB2(o2[0]=__builtin_amdgcn_mfma_f32_32x32x16_bf16(PAF(0),V2FR(0),o2[0],0,0,0), C1,0); \
    GAPB2(o2[1]=__builtin_amdgcn_mfma_f32_32x32x16_bf16(PAF(0),V2FR(4),o2[1],0,0,0), C1,2); \
    GAPB2(o2[0]=__builtin_amdgcn_mfma_f32_32x32x16_bf16(PAF(1),V2FR(1),o2[0],0,0,0), C1,4); \
    GAPB2(o2[1]=__builtin_amdgcn_mfma_f32_32x32x16_bf16(PAF(1),V2FR(5),o2[1],0,0,0), C1,6); \
    GAPB2(o2[0]=__builtin_amdgcn_mfma_f32_32x32x16_bf16(PAF(2),V2FR(2),o2[0],0,0,0), C1,8); \
    GAPB2(o2[1]=__builtin_amdgcn_mfma_f32_32x32x16_bf16(PAF(2),V2FR(6),o2[1],0,0,0), C1,10); \
    GAPB2(o2[0]=__builtin_amdgcn_mfma_f32_32x32x16_bf16(PAF(3),V2FR(3),o2[0],0,0,0), C1,12); \
    GAPB2(o2[1]=__builtin_amdgcn_mfma_f32_32x32x16_bf16(PAF(3),V2FR(7),o2[1],0,0,0), C1,14); \
    }while(0)
  int t=1;
  #undef CMASK
  #define CMASK(P0,P1,t) do{}while(0)
  for(;t+5<NT;t+=2){
    STEP(pB0,pB1,pA0,pA1,t,true,true,true);     WAIT_BAR(3); RESC(); ROT();
    STEP(pA0,pA1,pB0,pB1,t+1,true,true,true);   WAIT_BAR(3); RESC(); ROT();
  }
  #undef CMASK
  #define CMASK(P0,P1,t) do{int jb_=(t)-(NT-4); if(jb_>=0)cmask(P0,P1,jb_,qrel,hi);}while(0)
  #define ENDW(tt) do{ if((tt)+3<NT){WAIT_BAR(3);} else if((tt)+2<NT){WAIT_BAR(2);} else {WAIT_BAR(0);} }while(0)
  for(;t+1<NT;t+=2){
    STEP(pB0,pB1,pA0,pA1,t,(t+3<NT),(t+1<NT),(t+1<NT));       ENDW(t);   RESC(); ROT();
    STEP(pA0,pA1,pB0,pB1,t+1,(t+4<NT),(t+2<NT),(t+2<NT));     ENDW(t+1); RESC(); ROT();
  }
  STEP(pB0,pB1,pA0,pA1,NT-1,false,false,false); RESC();
  { float sacc=pB0[0]+pB0[1]; _Pragma("unroll") for(int r=2;r<16;++r)sacc+=pB0[r]; _Pragma("unroll") for(int r=0;r<16;++r)sacc+=pB1[r]; l_reg+=sacc;
    pw0=(u32x4){PKW(pB0,0),PKW(pB0,2),PKW(pB0,4),PKW(pB0,6)};pw1=(u32x4){PKW(pB0,8),PKW(pB0,10),PKW(pB0,12),PKW(pB0,14)};pw2=(u32x4){PKW(pB1,0),PKW(pB1,2),PKW(pB1,4),PKW(pB1,6)};pw3=(u32x4){PKW(pB1,8),PKW(pB1,10),PKW(pB1,12),PKW(pB1,14)};
    SBAR(); pv(o,vb0+sl_cur,PAF(0),PAF(1),PAF(2),PAF(3)); pv(o2,vb0+(LDS_V2-LDS_V)+sl_cur,PAF(0),PAF(1),PAF(2),PAF(3)); }
  #undef PKW
  #undef PAF
  #undef VFR
  #undef PIN
  #undef MX3
  #undef GAPA
  #undef GAPB
  #undef EX
  #undef VRD
  #undef VRD2
  #undef V2FR
  #undef GAPB2
  #undef KRD
  #undef STEP
  #undef ENDW
  {auto rr=__builtin_amdgcn_permlane32_swap(__float_as_uint(l_reg),__float_as_uint(l_reg),false,false);l_reg=__uint_as_float(rr[0])+__uint_as_float(rr[1]);}
  if(hi==0)wsf[32+r32]=l_reg;asm volatile("s_waitcnt lgkmcnt(0)":::"memory");
  float rli[16];
  #pragma unroll
  for(int r=0;r<16;++r)rli[r]=__builtin_amdgcn_rcpf(wsf[32+crow(r,hi)]);
  bf16*O,*O2,*YA; const float*sw; { unsigned char*w_=wsb; asm volatile("":"+s"(w_)); O=(bf16*)(w_+AWS_OLO); O2=(bf16*)(w_+AWS_OHI); YA=(bf16*)(w_+AWS_YA); sw=(const float*)(w_+AWS_SW); }
  u32x4 mine[2][4];
  #pragma unroll
  for(int ob=0;ob<2;++ob){ bf16*Ow=(ob?O2:O)+(rowbase+q0+wid*QBLK)*DM+h*D;
    bf16*stg=(bf16*)(shm+LDS_OST)+wid*2048;
    #pragma unroll
    for(int r=0;r<16;++r){const int orow=crow(r,hi);
      #pragma unroll
      for(int d0=0;d0<2;++d0)stg[orow*64+d0*32+r32]=__float2bfloat16((ob?o2[d0][r]:o[d0][r])*rli[r]);}
    asm volatile("s_waitcnt lgkmcnt(0)":::"memory");
    #pragma unroll
    for(int i=0;i<4;++i){const int row=i*8+(lane>>3),ch=lane&7; const u32x4 v=*(const u32x4*)(stg+row*64+ch*8); if(CMB==0){ATTN_STORE16(Ow+(long)row*DM+ch*8,v);} else mine[ob][i]=v;}
    asm volatile("s_waitcnt lgkmcnt(0)":::"memory"); }
  if(CMB==1){
    const int ch=lane&7; const bf16*P1lo=O+(rowbase+q0+wid*QBLK)*DM+(h-1)*D+ch*8,*P1hi=O2+(rowbase+q0+wid*QBLK)*DM+(h-1)*D+ch*8;
    float swl[8],swh[8];
    #pragma unroll
    for(int e=0;e<8;++e){swl[e]=sw[ch*8+e];swh[e]=sw[64+ch*8+e];}
    bf16*Yw=YA+(rowbase+q0+wid*QBLK)*(long)ya_pitch+(h>>1)*128+ch*8;
    u32x4 p1[2][4];
    #pragma unroll
    for(int i=0;i<4;++i){const int row=i*8+(lane>>3); p1[0][i]=*(const u32x4*)(P1lo+(long)row*DM); p1[1][i]=*(const u32x4*)(P1hi+(long)row*DM);}
    #pragma unroll
    for(int i=0;i<4;++i){const int row=i*8+(lane>>3); float a_[16]; float ss=0.f;
      #pragma unroll
      for(int t=0;t<2;++t)
        #pragma unroll
        for(int e=0;e<4;++e){const unsigned w1=p1[t][i][e],w2=mine[t][i][e];
          const float x0=__uint_as_float(w1<<16)-lam*__uint_as_float(w2<<16), x1=__uint_as_float(w1&0xffff0000u)-lam*__uint_as_float(w2&0xffff0000u);
          a_[t*8+2*e]=x0;a_[t*8+2*e+1]=x1;ss+=x0*x0+x1*x1;}
      ss+=__shfl_xor(ss,1);ss+=__shfl_xor(ss,2);ss+=__shfl_xor(ss,4);
      const float rn=1.0f/sqrtf(ss*(1.f/128.f)+1e-6f);
      u32x4 ylo,yhi;
      #pragma unroll
      for(int e=0;e<4;++e){ylo[e]=cvtpk_s(a_[2*e]*rn*swl[2*e],a_[2*e+1]*rn*swl[2*e+1]);yhi[e]=cvtpk_s(a_[8+2*e]*rn*swh[2*e],a_[8+2*e+1]*rn*swh[2*e+1]);}
      *(u32x4*)(Yw+(long)row*ya_pitch)=ylo; *(u32x4*)(Yw+(long)row*ya_pitch+64)=yhi; }
  }
  asm volatile("s_waitcnt lgkmcnt(0)\n\ts_barrier":::"memory");
  #undef DMA_K
  #undef DMA_V
  #undef CMASK
  #undef START
  #undef RESC
  #undef ROT
}
constexpr int ATTN_LDS_BYTES=LDS_BYTES;

#undef SBAR
#undef WAIT_BAR
}
#include <hip/hip_cooperative_groups.h>
namespace cg = cooperative_groups;

#define LAS __attribute__((address_space(3)))
typedef unsigned short bf16;
typedef unsigned u32x4v __attribute__((ext_vector_type(4)));
typedef unsigned u32x2v __attribute__((ext_vector_type(2)));
typedef float f32x4 __attribute__((ext_vector_type(4)));
typedef float f32x16v __attribute__((ext_vector_type(16)));
typedef short bf16x8v __attribute__((ext_vector_type(8)));

constexpr int NWAVES = 8, NTHR = NWAVES * 64;
constexpr int BATCH = 4, SEQ = 8192, DMOD = 2048, M = BATCH * SEQ;
constexpr int AW = 1024, FF = 5632, NIN = 8192, NGU = 2 * FF;
constexpr float EPS = 1e-6f;
constexpr int LDS_BYTES = 132096;
constexpr float LOG2E = 1.4426950408889634f;

constexpr size_t MiB = 1u << 20;
constexpr size_t WS_KMAX = 512 * 1024;
constexpr size_t WS_ABAR = 1 * MiB, WS_BF = 1 * MiB + 64 * 1024, WS_CF = 1 * MiB + 512 * 1024;
constexpr size_t WS_WIN = 2 * MiB, WS_WGLU = 34 * MiB, WS_WA = 36 * MiB, WS_WS = 40 * MiB, WS_WOUT = 44 * MiB, WS_WGU = 52 * MiB, WS_WD = 96 * MiB;
constexpr size_t WS_WG8 = 18 * MiB;
constexpr size_t WS_U8 = 768 * MiB;
constexpr int FFN_H8 = 1536, FFN_T8 = FFN_H8 / 128, ACT_PITCH = FFN_H8 + 2 * (FF - FFN_H8);
constexpr float ACT_S8 = 8.f, WD_S8 = 64.f;
constexpr float GATE_WSCALE = 64.f;
constexpr size_t WS_U = 128 * MiB;
constexpr size_t WS_Q = 256 * MiB, WS_K = 320 * MiB, WS_V = 384 * MiB, WS_SIN = 448 * MiB;
constexpr size_t WS_GA = 512 * MiB, WS_GS = 640 * MiB;
constexpr size_t WS_OLO = 768 * MiB, WS_OHI = 832 * MiB, WS_YS = 896 * MiB;
constexpr size_t WS_SW = 768 * 1024;
constexpr size_t WS_YA = 128 * MiB  , WS_YS2 = 320 * MiB, WS_T1 = 384 * MiB, WS_MERGED = 768 * MiB, WS_MIX = 640 * MiB;
constexpr size_t WS_ACT = 256 * MiB, WS_F = 768 * MiB, WS_END = 960 * MiB;

__device__ __forceinline__ float bf_lo(unsigned u) { return __uint_as_float(u << 16); }
__device__ __forceinline__ float bf_hi(unsigned u) { return __uint_as_float(u & 0xffff0000u); }
__device__ __forceinline__ unsigned pkbf(float lo, float hi) { return pg8::cvt_pk_bf16(lo, hi); }
__device__ __forceinline__ float sigmoidf_(float x) { return __builtin_amdgcn_rcpf(1.0f + __builtin_amdgcn_exp2f(-LOG2E * x)); }
__device__ __forceinline__ void unpack8(const u32x4v w, f32x4& lo, f32x4& hi) {
    lo[0] = bf_lo(w.x); lo[1] = bf_hi(w.x); lo[2] = bf_lo(w.y); lo[3] = bf_hi(w.y); hi[0] = bf_lo(w.z); hi[1] = bf_hi(w.z); hi[2] = bf_lo(w.w); hi[3] = bf_hi(w.w); }
__device__ __forceinline__ u32x4v pack8(const f32x4 a, const f32x4 b) { u32x4v w; w.x = pkbf(a[0], a[1]); w.y = pkbf(a[2], a[3]); w.z = pkbf(b[0], b[1]); w.w = pkbf(b[2], b[3]); return w; }
__device__ __forceinline__ float wave_sum(float v) {
#pragma unroll
    for (int o = 1; o < 64; o <<= 1) v += __shfl_xor(v, o);
    return v;
}

__device__ __forceinline__ unsigned pk4_fp8(float a, float b, float cc, float d) { int w = 0; w = __builtin_amdgcn_cvt_pk_fp8_f32(a, b, w, false); w = __builtin_amdgcn_cvt_pk_fp8_f32(cc, d, w, true); return (unsigned)w; }
namespace epi {
using pg8::Unit; using pg8::BM; using pg8::HALF; using pg8::bf16_t;
struct InProj {
    static constexpr bool PERM = true, AFTER_DRAIN = false, MID_HOOK = false;
    unsigned* kmax2;
    bf16_t* qkvs; bf16_t* gates; float qscale; int col_base; float gscale;
    __device__ __forceinline__ void operator()(const pg8::f32x4 (&acc)[2][2][4][2], const Unit& u, int wr, int wc, int fr, int fq) const {
        const int row0 = u.pm * BM + wr * 64 + fr; int colt = col_base + u.pn * BM; bf16_t* base; int ldc; int mode;
        if (colt < 4096) { const int t = colt >> 10; base = qkvs + (size_t)t * ((size_t)M * 1024); ldc = 1024; colt &= 1023; mode = (t == 0) ? 1 : 0; }
        else { const int t = (colt - 4096) >> 11; base = gates + (size_t)t * ((size_t)M * 2048); ldc = 2048; colt = (colt - 4096) & 2047; mode = 2; }
        const int col0 = colt + wc * 32 + 8 * fq;
        if (kmax2 && mode == 0 && (col_base + u.pn * BM) >= 1024 && (col_base + u.pn * BM) < 2048) {
#pragma unroll
            for (int bj = 0; bj < 2; ++bj) { float mx = 0.f;
#pragma unroll
                for (int ai = 0; ai < 2; ++ai)
#pragma unroll
                    for (int m = 0; m < 4; ++m) { const pg8::f32x4 a = acc[ai][bj][m][0], b = acc[ai][bj][m][1];
                        float ss = (a[0] * a[0] + a[1] * a[1]) + (a[2] * a[2] + a[3] * a[3]) + (b[0] * b[0] + b[1] * b[1]) + (b[2] * b[2] + b[3] * b[3]);
                        ss += __shfl_xor(ss, 16); ss += __shfl_xor(ss, 32); mx = fmaxf(mx, ss); }
                mx = fmaxf(mx, __shfl_xor(mx, 1)); mx = fmaxf(mx, __shfl_xor(mx, 2)); mx = fmaxf(mx, __shfl_xor(mx, 4)); mx = fmaxf(mx, __shfl_xor(mx, 8));
                if (fr == 0 && fq == 0) { const int bidx = (u.pm * BM) / SEQ, head = ((colt >> 6) + 2 * bj + (wc >> 1));
                    __hip_atomic_fetch_max(kmax2 + (bidx * 16 + head) * 2 + (wc & 1), __float_as_uint(mx), __ATOMIC_RELAXED, __HIP_MEMORY_SCOPE_AGENT); } }
        }
#pragma unroll
        for (int ai = 0; ai < 2; ++ai)
#pragma unroll
            for (int m = 0; m < 4; ++m) { bf16_t* rowp = base + (size_t)(row0 + ai * HALF + m * 16) * ldc + col0;
#pragma unroll
                for (int bj = 0; bj < 2; ++bj) { pg8::f32x4 v0 = acc[ai][bj][m][0], v1 = acc[ai][bj][m][1];
                    if (mode == 1) { v0 = v0 * qscale; v1 = v1 * qscale; }
                    else if (mode == 2) {
#pragma unroll
                        for (int e = 0; e < 4; ++e) { v0[e] = sigmoidf_(v0[e] * gscale); v1[e] = sigmoidf_(v1[e] * gscale); } }
                    *(u32x4v*)(rowp + bj * HALF) = pack8(v0, v1); } }
    }
};
template <int MODE> struct Ew {
    static constexpr bool PERM = true, AFTER_DRAIN = false, MID_HOOK = false;
    bf16_t* O; int ldc; const bf16_t* aux1; const bf16_t* aux2; const float* bias; int lda;
    __device__ __forceinline__ void operator()(const pg8::f32x4 (&acc)[2][2][4][2], const Unit& u, int wr, int wc, int fr, int fq) const {
        const int row0 = u.pm * BM + wr * 64 + fr; const int col0 = u.pn * BM + wc * 32 + 8 * fq;
        pg8::f32x4 bv[2][2];
#pragma unroll
        for (int bj = 0; bj < 2; ++bj)
#pragma unroll
            for (int n = 0; n < 2; ++n) bv[bj][n] = (MODE == 2) ? *(const pg8::f32x4*)(bias + col0 + bj * HALF + 4 * n) : (pg8::f32x4){0.f, 0.f, 0.f, 0.f};
#pragma unroll
        for (int ai = 0; ai < 2; ++ai)
#pragma unroll
            for (int m = 0; m < 4; ++m) { const size_t ro = (size_t)(row0 + ai * HALF + m * 16) * ldc + col0, rx = (size_t)(row0 + ai * HALF + m * 16) * lda + col0;
#pragma unroll
                for (int bj = 0; bj < 2; ++bj) { const size_t o = ro + bj * HALF, ox = rx + bj * HALF; pg8::f32x4 v0 = acc[ai][bj][m][0], v1 = acc[ai][bj][m][1];
                    if (MODE == 2) { f32x4 a0, a1; unpack8(*(const u32x4v*)(aux1 + ox), a0, a1); v0 = v0 + bv[bj][0]; v1 = v1 + bv[bj][1];
#pragma unroll
                        for (int e = 0; e < 4; ++e) { v0[e] = a0[e] * sigmoidf_(v0[e]); v1[e] = a1[e] * sigmoidf_(v1[e]); } }
                    if (MODE == 3) { f32x4 a0, a1; unpack8(*(const u32x4v*)(aux1 + ox), a0, a1); v0 = v0 * a0; v1 = v1 * a1; }
                    if (MODE == 4) { f32x4 a0, a1, g0, g1; unpack8(*(const u32x4v*)(aux1 + ox), a0, a1); unpack8(*(const u32x4v*)(aux2 + ox), g0, g1); v0 = a0 + g0 * v0; v1 = a1 + g1 * v1; }
                    *(u32x4v*)(O + o) = pack8(v0, v1); } }
    }
};
struct Gated {
    static constexpr bool PERM = true, AFTER_DRAIN = false, MID_HOOK = true;
    bf16_t* O; int ldc; const bf16_t* ga; const bf16_t* gs;
    __device__ __forceinline__ int mid_t(int nt) const { return nt >> 1; }
    __device__ __forceinline__ void mid(pg8::f32x4 (&acc)[2][2][4][2], const Unit& u, int wr, int wc, int fr, int fq) const {
        int row0 = u.pm * BM + wr * 64 + fr; const int col0 = u.pn * BM + wc * 32 + 8 * fq;
        asm volatile("" : "+v"(row0));
#pragma unroll
        for (int ai = 0; ai < 2; ++ai)
#pragma unroll
            for (int m = 0; m < 4; ++m) { const size_t ro = (size_t)(row0 + ai * HALF + m * 16) * ldc + col0;
#pragma unroll
                for (int bj = 0; bj < 2; ++bj) { const size_t o = ro + bj * HALF; f32x4 a0, a1, g0, g1; unpack8(*(const u32x4v*)(ga + o), a0, a1); unpack8(*(const u32x4v*)(gs + o), g0, g1);
#pragma unroll
                    for (int e = 0; e < 4; ++e) { acc[ai][bj][m][0][e] *= a0[e] * __builtin_amdgcn_rcpf(g0[e]); acc[ai][bj][m][1][e] *= a1[e] * __builtin_amdgcn_rcpf(g1[e]); } }
                if (m & 1) asm volatile("" ::: "memory"); }
    }
    __device__ __forceinline__ void operator()(const pg8::f32x4 (&acc)[2][2][4][2], const Unit& u, int wr, int wc, int fr, int fq) const {
        const int row0 = u.pm * BM + wr * 64 + fr; const int col0 = u.pn * BM + wc * 32 + 8 * fq;
#pragma unroll
        for (int ai = 0; ai < 2; ++ai)
#pragma unroll
            for (int m = 0; m < 4; ++m) { const size_t ro = (size_t)(row0 + ai * HALF + m * 16) * ldc + col0;
#pragma unroll
                for (int bj = 0; bj < 2; ++bj) { const size_t o = ro + bj * HALF; f32x4 g0, g1; unpack8(*(const u32x4v*)(gs + o), g0, g1);
                    *(u32x4v*)(O + o) = pack8(acc[ai][bj][m][0] * g0, acc[ai][bj][m][1] * g1); } }
    }
};
struct PlainMix {
    static constexpr bool PERM = true, AFTER_DRAIN = false, MID_HOOK = true;
    bf16_t* O; int ldc; int t8; float undo;
    __device__ __forceinline__ int mid_t(int) const { return t8; }
    __device__ __forceinline__ void mid(pg8::f32x4 (&acc)[2][2][4][2], const Unit&, int, int, int, int) const {
#pragma unroll
        for (int ai = 0; ai < 2; ++ai)
#pragma unroll
            for (int bj = 0; bj < 2; ++bj)
#pragma unroll
                for (int m = 0; m < 4; ++m) { acc[ai][bj][m][0] = acc[ai][bj][m][0] * undo; acc[ai][bj][m][1] = acc[ai][bj][m][1] * undo; }
    }
    __device__ __forceinline__ void operator()(const pg8::f32x4 (&acc)[2][2][4][2], const Unit& u, int wr, int wc, int fr, int fq) const {
        const int row0 = u.pm * BM + wr * 64 + fr; const int col0 = u.pn * BM + wc * 32 + 8 * fq;
#pragma unroll
        for (int ai = 0; ai < 2; ++ai)
#pragma unroll
            for (int m = 0; m < 4; ++m) { const size_t ro = (size_t)(row0 + ai * HALF + m * 16) * ldc + col0;
#pragma unroll
                for (int bj = 0; bj < 2; ++bj) *(u32x4v*)(O + ro + bj * HALF) = pack8(acc[ai][bj][m][0], acc[ai][bj][m][1]); }
    }
};
struct SwiGlu {
    static constexpr bool PERM = true, AFTER_DRAIN = false, MID_HOOK = false;
    unsigned char* O; int pitch; int h8; float s8;
    __device__ __forceinline__ void operator()(const pg8::f32x4 (&acc)[2][2][4][2], const Unit& u, int wr, int wc, int fr, int fq) const {
        const int row0 = u.pm * BM + wr * 64 + fr; const int col0 = u.pn * HALF + wc * 32 + 8 * fq; const bool f8 = (u.pn * HALF) < h8;
#pragma unroll
        for (int ai = 0; ai < 2; ++ai)
#pragma unroll
            for (int m = 0; m < 4; ++m) { pg8::f32x4 g0 = acc[ai][0][m][0], g1 = acc[ai][0][m][1]; const pg8::f32x4 u0 = acc[ai][1][m][0], u1 = acc[ai][1][m][1];
#pragma unroll
                for (int e = 0; e < 4; ++e) { g0[e] = g0[e] * sigmoidf_(g0[e]) * u0[e]; g1[e] = g1[e] * sigmoidf_(g1[e]) * u1[e]; }
                unsigned char* rowp = O + (size_t)(row0 + ai * HALF + m * 16) * pitch;
                if (f8) { u32x2v o; o.x = pk4_fp8(g0[0] * s8, g0[1] * s8, g0[2] * s8, g0[3] * s8); o.y = pk4_fp8(g1[0] * s8, g1[1] * s8, g1[2] * s8, g1[3] * s8); *(u32x2v*)(rowp + col0) = o; }
                else *(u32x4v*)(rowp + h8 + 2 * (col0 - h8)) = pack8(g0, g1); }
    }
};
}

__device__ __forceinline__ void p0_transpose_item(const float* W, int K, int N, bf16* WT, int gu, LAS float* scr, int item, int lane, int ldk = 0, int koff = 0) {
    if (ldk == 0) ldk = K;
    const int nblk = N / 32, kb = item / nblk, nb = item % nblk, k0 = 64 * kb, n0 = 32 * nb;
    int drow0 = n0; if (gu) drow0 = (n0 >> 7) * 256 + (n0 & 127) + (gu == 2 ? 128 : 0);
#pragma unroll 8
    for (int i = 0; i < 32; ++i) { const int kk = 2 * i + (lane >> 5); scr[kk * 33 + (lane & 31)] = W[(size_t)(k0 + kk) * N + n0 + (lane & 31)]; }
    asm volatile("s_waitcnt lgkmcnt(0)" ::: "memory");
    const int c = lane & 7;
#pragma unroll
    for (int j = 0; j < 4; ++j) { const int n = (lane >> 3) + 8 * j; const LAS float* s = scr + (8 * c) * 33 + n;
        u32x4v o; o.x = pkbf(s[0 * 33], s[1 * 33]); o.y = pkbf(s[2 * 33], s[3 * 33]); o.z = pkbf(s[4 * 33], s[5 * 33]); o.w = pkbf(s[6 * 33], s[7 * 33]);
        *(u32x4v*)(WT + (size_t)(drow0 + n) * ldk + koff + k0 + 8 * c) = o; }
    asm volatile("s_waitcnt lgkmcnt(0)" ::: "memory");
}
__device__ __forceinline__ void p0_transpose_item_fp8(const float* W, int K, int N, unsigned char* WT, int drow0, float scale, LAS float* scr, int k0, int n0, int lane) {
#pragma unroll 8
    for (int i = 0; i < 32; ++i) { const int kk = 2 * i + (lane >> 5); scr[kk * 33 + (lane & 31)] = W[(size_t)(k0 + kk) * N + n0 + (lane & 31)]; }
    asm volatile("s_waitcnt lgkmcnt(0)" ::: "memory");
    const int c = lane & 7;
#pragma unroll
    for (int j = 0; j < 4; ++j) { const int n = (lane >> 3) + 8 * j; const LAS float* s = scr + (8 * c) * 33 + n;
        u32x2v o; o.x = pk4_fp8(s[0 * 33] * scale, s[1 * 33] * scale, s[2 * 33] * scale, s[3 * 33] * scale); o.y = pk4_fp8(s[4 * 33] * scale, s[5 * 33] * scale, s[6 * 33] * scale, s[7 * 33] * scale);
        *(u32x2v*)(WT + (size_t)(drow0 + n) * K + k0 + 8 * c) = o; }
    asm volatile("s_waitcnt lgkmcnt(0)" ::: "memory");
}
__device__ __forceinline__ void cvt_item(const float* W, int K, int N, bf16* WT, int gu, int item, int lane, int ldk = 0, int koff = 0) {
    if (ldk == 0) ldk = K;
    const int nblk = N / 32, kb = item / nblk, nb = item % nblk, k0 = 64 * kb, n0 = 32 * nb, n = lane & 31, kh = lane >> 5;
    int drow0 = n0; if (gu) drow0 = (n0 >> 7) * 256 + (n0 & 127) + (gu == 2 ? 128 : 0);
    float v[32];
#pragma unroll
    for (int i = 0; i < 32; ++i) v[i] = W[(size_t)(k0 + 32 * kh + i) * N + n0 + n];
#pragma unroll
    for (int c4 = 0; c4 < 4; ++c4) { u32x4v o; o.x = pkbf(v[8 * c4], v[8 * c4 + 1]); o.y = pkbf(v[8 * c4 + 2], v[8 * c4 + 3]); o.z = pkbf(v[8 * c4 + 4], v[8 * c4 + 5]); o.w = pkbf(v[8 * c4 + 6], v[8 * c4 + 7]);
        *(u32x4v*)(WT + (size_t)(drow0 + n) * ldk + koff + k0 + 32 * kh + 8 * c4) = o; }
}
__device__ __forceinline__ void cvt_item_fp8(const float* W, int K  , int N, unsigned char* WT, int drow0, float scale, int k0, int n0, int lane) {
    const int n = lane & 31, kh = lane >> 5;
    float v[32];
#pragma unroll
    for (int i = 0; i < 32; ++i) v[i] = W[(size_t)(k0 + 32 * kh + i) * N + n0 + n] * scale;
#pragma unroll
    for (int c4 = 0; c4 < 4; ++c4) { u32x2v o; o.x = pk4_fp8(v[8 * c4], v[8 * c4 + 1], v[8 * c4 + 2], v[8 * c4 + 3]); o.y = pk4_fp8(v[8 * c4 + 4], v[8 * c4 + 5], v[8 * c4 + 6], v[8 * c4 + 7]);
        *(u32x2v*)(WT + (size_t)(drow0 + n) * K + k0 + 32 * kh + 8 * c4) = o; }
}
__device__ __forceinline__ void rms_row_to_bf16(const float* xrow, const float* w, bf16* orow, unsigned char* orow8, int lane) {
    const f32x4* xr = (const f32x4*)xrow + lane; const f32x4* wr = (const f32x4*)w + lane;
    f32x4 v[8]; float s = 0.f;
#pragma unroll
    for (int j = 0; j < 8; ++j) { v[j] = xr[64 * j]; s += (v[j].x * v[j].x + v[j].y * v[j].y) + (v[j].z * v[j].z + v[j].w * v[j].w); }
    const float r = 1.0f / sqrtf(wave_sum(s) * (1.f / DMOD) + EPS);
    u32x2v* o8 = (u32x2v*)orow + lane;
#pragma unroll
    for (int j = 0; j < 8; ++j) { const f32x4 ww = wr[64 * j]; const f32x4 y = v[j] * r * ww; u32x2v o; o.x = pkbf(y.x, y.y); o.y = pkbf(y.z, y.w); o8[64 * j] = o;
        ((unsigned*)orow8)[lane + 64 * j] = pk4_fp8(y.x, y.y, y.z, y.w); }
}
__device__ __forceinline__ double dexp(double x) {
    const double y = x * (1.0 / 64.0); double t = 1.0, s = 1.0;
    for (int k = 1; k <= 14; ++k) { t *= y / (double)k; s += t; }
    for (int i = 0; i < 6; ++i) s *= s;
    return s;
}
__device__ __forceinline__ void dsincos(double th, double& sn, double& cs) {
    const double TWO_PI = 6.283185307179586476925;
    const double r = th - TWO_PI * __builtin_rint(th / TWO_PI), r2 = r * r;
    double ts = r, tc = 1.0; sn = r; cs = 1.0;
    for (int k = 1; k <= 17; ++k) { tc *= -r2 / (double)((2 * k - 1) * (2 * k)); cs += tc; ts *= -r2 / (double)((2 * k) * (2 * k + 1)); sn += ts; }
}
__device__ __forceinline__ void ssm_param(int g, int p, const float* a_re, const float* a_im, const float* log_dt, const float* b_re, const float* b_im, const float* c_re, const float* c_im,
                                          float* ABAR, bf16* BF, bf16* CF) {
    const double dt = dexp((double)log_dt[g]);
    const double lr = (double)a_re[g * 64 + p], li = (double)a_im[g * 64 + p];
    const double mag = dexp(lr * dt); double sn, cs; dsincos(li * dt, sn, cs);
    const double ar = mag * cs, ai = mag * sn;
    ABAR[(g * 64 + p) * 2 + 0] = (float)ar; ABAR[(g * 64 + p) * 2 + 1] = (float)ai;
    const double nr = ar - 1.0, ni = ai, den = lr * lr + li * li;
    const double cr = (nr * lr + ni * li) / den, ci = (ni * lr - nr * li) / den;
    const int n = p >> 1, jodd = p & 1;
    for (int h = 0; h < 16; ++h) {
        const double br = (double)b_re[(g * 64 + p) * 16 + h], bi = (double)b_im[(g * 64 + p) * 16 + h];
        const float bbr = (float)(cr * br - ci * bi), bbi = (float)(cr * bi + ci * br);
        const int hi = h >> 3, jj = h & 7;
        BF[((size_t)(g * 4 + 0 + jodd) * 64 + (n + 32 * hi)) * 8 + jj] = (bf16)(pkbf(bbr, 0.f) & 0xffffu);
        BF[((size_t)(g * 4 + 2 + jodd) * 64 + (n + 32 * hi)) * 8 + jj] = (bf16)(pkbf(bbi, 0.f) & 0xffffu);
    }
    for (int comp = 0; comp < 2; ++comp) { const int k = p + 64 * comp, kk = k >> 5, kg = (k >> 3) & 3, jj = k & 7;
        for (int ch = 0; ch < 16; ++ch) { const float v = comp == 0 ? c_re[(g * 16 + ch) * 64 + p] : -c_im[(g * 16 + ch) * 64 + p];
            CF[((size_t)(g * 4 + kk) * 64 + (ch + 16 * kg)) * 8 + jj] = (bf16)(pkbf(v, 0.f) & 0xffffu); } }
}

__device__ __forceinline__ float gelu_tanh(float x) { const float z = 0.7978845608028654f * (x + 0.044715f * x * x * x); return x * sigmoidf_(2.0f * z); }
__device__ __forceinline__ void ssm_phase(LAS unsigned char* lds, const bf16* SIN, const float* ABAR, const bf16* BF, const bf16* CF, const float* dskip, bf16* YS, int wid, int lane, int G) {
    typedef float f32x2v __attribute__((ext_vector_type(2)));
    LAS f32x2v* END = (LAS f32x2v*)lds;
    LAS unsigned char* tile = lds + 8192 + wid * 8704;
    const int n = lane & 31, hi = lane >> 5;
    for (int unit = blockIdx.x; unit < BATCH * 64; unit += G) {
        const int b = unit >> 6, g = unit & 63;
        const f32x2v aA = *(const f32x2v*)(ABAR + (g * 64 + 2 * n) * 2), aB = *(const f32x2v*)(ABAR + (g * 64 + 2 * n + 1) * 2);
        bf16x8v bfr[4], cfr[4];
#pragma unroll
        for (int j = 0; j < 4; ++j) { bfr[j] = *(const bf16x8v*)(BF + ((size_t)(g * 4 + j) * 64 + lane) * 8); cfr[j] = *(const bf16x8v*)(CF + ((size_t)(g * 4 + j) * 64 + lane) * 8); }
        const int aseg = (n >> 2) & 1, atok = (n & 3) + 4 * (n >> 3);
        const bf16* uptr = SIN + ((size_t)b * SEQ + (size_t)(2 * wid + aseg) * 512 + atok) * 1024 + g * 16 + 8 * hi;
        float sAr = 0.f, sAi = 0.f, sBr = 0.f, sBi = 0.f;
        const f32x16v zero16 = {0.f, 0.f, 0.f, 0.f, 0.f, 0.f, 0.f, 0.f, 0.f, 0.f, 0.f, 0.f, 0.f, 0.f, 0.f, 0.f};
#define SSM_SCAN(r) { const float nAr = fmaf(-aA.y, sAi, fmaf(aA.x, sAr, D0[r])), nAi = fmaf(aA.y, sAr, fmaf(aA.x, sAi, D2[r])); \
                      const float nBr = fmaf(-aB.y, sBi, fmaf(aB.x, sBr, D1[r])), nBi = fmaf(aB.y, sBr, fmaf(aB.x, sBi, D3[r])); sAr = nAr; sAi = nAi; sBr = nBr; sBi = nBi; }
        {
            bf16x8v ua = *(const bf16x8v*)uptr;
            for (int it = 0; it < 32; ++it) {
                const bf16x8v un = *(const bf16x8v*)(uptr + (size_t)((it + 1 < 32) ? it + 1 : it) * 16 * 1024);
                const f32x16v D0 = __builtin_amdgcn_mfma_f32_32x32x16_bf16(ua, bfr[0], zero16, 0, 0, 0), D1 = __builtin_amdgcn_mfma_f32_32x32x16_bf16(ua, bfr[1], zero16, 0, 0, 0);
                const f32x16v D2 = __builtin_amdgcn_mfma_f32_32x32x16_bf16(ua, bfr[2], zero16, 0, 0, 0), D3 = __builtin_amdgcn_mfma_f32_32x32x16_bf16(ua, bfr[3], zero16, 0, 0, 0);
#pragma unroll
                for (int r = 0; r < 16; ++r) SSM_SCAN(r)
                ua = un;
            }
        }
        END[(2 * wid + hi) * 64 + 2 * n] = (f32x2v){sAr, sAi}; END[(2 * wid + hi) * 64 + 2 * n + 1] = (f32x2v){sBr, sBi};
        __syncthreads();
        {
            f32x2v pA = aA, pB = aB;
#pragma unroll
            for (int i = 0; i < 9; ++i) { pA = (f32x2v){pA.x * pA.x - pA.y * pA.y, 2.f * pA.x * pA.y}; pB = (f32x2v){pB.x * pB.x - pB.y * pB.y, 2.f * pB.x * pB.y}; }
            sAr = 0.f; sAi = 0.f; sBr = 0.f; sBi = 0.f; const int myseg = 2 * wid + hi;
            for (int j = 0; j < 15; ++j) if (j < myseg) { const f32x2v eA = END[j * 64 + 2 * n], eB = END[j * 64 + 2 * n + 1];
                const float tAr = pA.x * sAr - pA.y * sAi + eA.x, tAi = pA.x * sAi + pA.y * sAr + eA.y, tBr = pB.x * sBr - pB.y * sBi + eB.x, tBi = pB.x * sBi + pB.y * sBr + eB.y;
                sAr = tAr; sAi = tAi; sBr = tBr; sBi = tBi; }
        }
        {
            const int tk = lane & 15, q4 = lane >> 4;
            const f32x4 dsk = *(const f32x4*)(dskip + g * 16 + 4 * q4);
            const size_t erow0 = (size_t)b * SEQ + (size_t)(2 * wid) * 512 + tk;
            bf16x8v ua = *(const bf16x8v*)uptr;
            for (int it = 0; it < 32; ++it) {
                const bf16x8v un = *(const bf16x8v*)(uptr + (size_t)((it + 1 < 32) ? it + 1 : it) * 16 * 1024);
                u32x2v uu[2];
#pragma unroll
                for (int s = 0; s < 2; ++s) uu[s] = *(const u32x2v*)(SIN + (erow0 + (size_t)s * 512 + (size_t)it * 16) * 1024 + g * 16 + 4 * q4);
                const f32x16v D0 = __builtin_amdgcn_mfma_f32_32x32x16_bf16(ua, bfr[0], zero16, 0, 0, 0), D1 = __builtin_amdgcn_mfma_f32_32x32x16_bf16(ua, bfr[1], zero16, 0, 0, 0);
                const f32x16v D2 = __builtin_amdgcn_mfma_f32_32x32x16_bf16(ua, bfr[2], zero16, 0, 0, 0), D3 = __builtin_amdgcn_mfma_f32_32x32x16_bf16(ua, bfr[3], zero16, 0, 0, 0);
#pragma unroll
                for (int r = 0; r < 16; ++r) { SSM_SCAN(r)
                    *(LAS unsigned*)(tile + (hi * 16 + r) * 272 + 4 * n) = pkbf(sAr, sBr); *(LAS unsigned*)(tile + (hi * 16 + r) * 272 + 128 + 4 * n) = pkbf(sAi, sBi); }
                asm volatile("s_waitcnt lgkmcnt(0)" ::: "memory");
#pragma unroll
                for (int s = 0; s < 2; ++s) {
                    f32x4 Y = {0.f, 0.f, 0.f, 0.f};
#pragma unroll
                    for (int kk = 0; kk < 4; ++kk) { const bf16x8v sf = *(const LAS bf16x8v*)(tile + (s * 16 + tk) * 272 + (32 * kk + 8 * q4) * 2);
                        Y = __builtin_amdgcn_mfma_f32_16x16x32_bf16(cfr[kk], sf, Y, 0, 0, 0); }
                    const float u0 = bf_lo(uu[s].x), u1 = bf_hi(uu[s].x), u2 = bf_lo(uu[s].y), u3 = bf_hi(uu[s].y);
                    const float y0 = gelu_tanh(Y[0] + dsk[0] * u0), y1 = gelu_tanh(Y[1] + dsk[1] * u1), y2 = gelu_tanh(Y[2] + dsk[2] * u2), y3 = gelu_tanh(Y[3] + dsk[3] * u3);
                    u32x2v o; o.x = pkbf(y0, y1); o.y = pkbf(y2, y3);
                    *(u32x2v*)(YS + (erow0 + (size_t)s * 512 + (size_t)it * 16) * 1024 + g * 16 + 4 * q4) = o;
                }
                asm volatile("s_waitcnt lgkmcnt(0)" ::: "memory");
                ua = un;
            }
        }
#undef SSM_SCAN
        __syncthreads();
    }
}

#define XB_TMO      128
#define XB_XCNT(j)  (256  + 64 * (j))
#define XB_XSUB(j)  (1280 + 64 * (j))
#define XB_XGEN(j)  (2304 + 64 * (j))
#define XB_TOP      3328
#define XB_TOPGEN   3392
#define XCD_BAR_WORDS 3456
#define XB_SPIN_CAP (1u << 18)

__device__ __forceinline__ unsigned xb_ld(unsigned* p)              { return __hip_atomic_load(p, __ATOMIC_RELAXED, __HIP_MEMORY_SCOPE_AGENT); }
__device__ __forceinline__ unsigned xb_add(unsigned* p, unsigned v) { return __hip_atomic_fetch_add(p, v, __ATOMIC_RELAXED, __HIP_MEMORY_SCOPE_AGENT); }
__device__ __forceinline__ unsigned xb_xcc_id() { return (unsigned)__builtin_amdgcn_s_getreg((3 << 11) | 20) & 0xFu; }
#define XB_SPIN(cond, bar) do { unsigned _sp = 0; while (cond) { __builtin_amdgcn_s_sleep(1); \
    if ((++_sp & 255u) == 0u) { if (xb_ld(&(bar)[XB_TMO])) break; if (_sp > XB_SPIN_CAP) { atomicAdd(&(bar)[XB_TMO], 1u); break; } } } } while (0)

struct XcdBarrier {
    unsigned* bar; unsigned x;
    volatile LAS unsigned* st;
};

__device__ __forceinline__ XcdBarrier xcd_barrier_post(unsigned* bar, volatile LAS unsigned* st) {
    XcdBarrier b; b.bar = bar; b.x = xb_xcc_id(); b.st = st;
    if (threadIdx.x == 0) (void)xb_add(&bar[XB_XCNT(b.x)], 1u);
    return b;
}
__device__ __forceinline__ void xcd_barrier_complete(unsigned* bar, unsigned x, unsigned& nloc, unsigned& nx) {
    const unsigned G = gridDim.x * gridDim.y * gridDim.z;
    unsigned sum, cnt, mine, sp = 0u;
    for (;;) {
        sum = 0u; cnt = 0u; mine = 0u;
#pragma unroll
        for (unsigned j = 0; j < 16; ++j) { const unsigned c = xb_ld(&bar[XB_XCNT(j)]); sum += c; cnt += (c > 0u) ? 1u : 0u; mine = (j == x) ? c : mine; }
        if (sum == G) break;
        __builtin_amdgcn_s_sleep(1);
        if ((++sp & 255u) == 0u) { if (xb_ld(&bar[XB_TMO])) break; if (sp > XB_SPIN_CAP) { atomicAdd(&bar[XB_TMO], 1u); break; } }
    }
    nloc = mine > 0u ? mine : 1u; nx = cnt > 0u ? cnt : 1u;
}

__device__ __forceinline__ void xcd_barrier(const XcdBarrier& b) {
    asm volatile("s_waitcnt vmcnt(0)" ::: "memory");
    __syncthreads();
    if (threadIdx.x == 0) {
        unsigned* bar = b.bar;
        __builtin_amdgcn_s_waitcnt(0);
        unsigned nloc = b.st[0], nx = b.st[1];
        if (nloc == 0u) { xcd_barrier_complete(bar, b.x, nloc, nx); b.st[0] = nloc; b.st[1] = nx; }
        const unsigned old = xb_add(&bar[XB_XSUB(b.x)], 1u);
        const unsigned gen = old / nloc;
        if (old + 1u == (gen + 1u) * nloc) {
            __builtin_amdgcn_fence(__ATOMIC_RELEASE, "agent");
            asm volatile("s_waitcnt vmcnt(0)" ::: "memory");
            const unsigned og = xb_add(&bar[XB_TOP], 1u);
            const unsigned tg = og / nx;
            if (og + 1u == (tg + 1u) * nx) xb_add(&bar[XB_TOPGEN], 1u);
            else XB_SPIN(xb_ld(&bar[XB_TOPGEN]) == tg, bar);
            __builtin_amdgcn_fence(__ATOMIC_ACQUIRE, "agent");
            xb_add(&bar[XB_XGEN(b.x)], 1u);
            asm volatile("s_waitcnt vmcnt(0)" ::: "memory");
        } else {
            XB_SPIN(xb_ld(&bar[XB_XGEN(b.x)]) == gen, bar);
            __builtin_amdgcn_fence(__ATOMIC_ACQUIRE, "agent");
            asm volatile("s_waitcnt vmcnt(0)" ::: "memory");
        }
    }
    __syncthreads();
}

struct Args { const float* in[27]; float* out; unsigned char* ws; };
typedef __attribute__((address_space(4))) const Args* KArgs;
__device__ __forceinline__ KArgs kargs_now() { KArgs p = (KArgs)__builtin_amdgcn_kernarg_segment_ptr(); asm volatile("" : "+s"(p)); return p; }
#define WSP(off) ((bf16*)(ws + (off)))
__device__ __forceinline__ void deferred_weight_copies() {
    const KArgs A = kargs_now(); unsigned char* const ws = A->ws;
    const int tid = tid_now(), lane = tid & 63, wave = __builtin_amdgcn_readfirstlane(tid >> 6), G = gridDim.x, bx = blockIdx.x;
    const int vcu = (G % 8 == 0) ? (bx % 8) * (G / 8) + bx / 8 : bx, gw = vcu * NWAVES + wave, NGW = G * NWAVES;
    constexpr int I1 = (1024 / 64) * (1024 / 32), I2 = (1024 / 64) * (2048 / 32), I3 = I2, I4 = (2048 / 64) * (2048 / 32), I5 = (2048 / 64) * (FF / 32), I6 = I5, I7 = (FF / 64) * (2048 / 32);
    constexpr int ND = I1 + I2 + I3 + I4 + I5 + I6 + I7;
#pragma unroll 1
    for (int it = gw; it < ND; it += NGW) {
        int r = it;
        if (r < I1) { cvt_item(A->in[15], 1024, 1024, WSP(WS_WGLU), 0, r, lane); continue; } r -= I1;
        if (r < I2) { cvt_item(A->in[17], 1024, 2048, WSP(WS_WA), 0, r, lane, 2048, 0); continue; } r -= I2;
        if (r < I3) { cvt_item(A->in[18], 1024, 2048, WSP(WS_WA), 0, r, lane, 2048, 1024); continue; } r -= I3;
        if (r < I4) { cvt_item(A->in[19], 2048, 2048, WSP(WS_WOUT), 0, r, lane); continue; } r -= I4;
        if (r < I5) { cvt_item(A->in[22], 2048, FF, WSP(WS_WGU), 1, r, lane); continue; } r -= I5;
        if (r < I6) { cvt_item(A->in[23], 2048, FF, WSP(WS_WGU), 2, r, lane); continue; } r -= I6;
        { const int nb = r % 64, kb = r / 64;
          if (64 * kb < FFN_H8) cvt_item_fp8(A->in[24], ACT_PITCH, 2048, ws + WS_WD, 32 * nb, WD_S8, 64 * kb, 32 * nb, lane);
          else cvt_item(A->in[24], FF, 2048, WSP(WS_WD), 0, r, lane, ACT_PITCH / 2, -(FFN_H8 / 2)); }
    }
}
__global__ void __launch_bounds__(NTHR, 2) fwd_megakernel(Args args_unused) {
    extern __shared__ __attribute__((aligned(16))) unsigned char lds_raw[];
    cg::grid_group grid = cg::this_grid();
    LAS unsigned char* lds = (LAS unsigned char*)lds_raw;
    volatile LAS unsigned* xst = (volatile LAS unsigned*)(lds + 131072);
    if (threadIdx.x < 2) xst[threadIdx.x] = 0u;
    __syncthreads();
#define PH_COMMON  const KArgs A = kargs_now(); unsigned char* const ws = A->ws; const int tid = tid_now(), lane = tid & 63, wave = __builtin_amdgcn_readfirstlane(tid >> 6); \
    const int G = gridDim.x, bx = blockIdx.x; const int vcu = (G % 8 == 0) ? (bx % 8) * (G / 8) + bx / 8 : bx; const int gw = vcu * NWAVES + wave, NGW = G * NWAVES; \
    (void)ws; (void)lane; (void)wave; (void)vcu; (void)gw; (void)NGW;

    {
        PH_COMMON
        LAS float* scr = (LAS float*)(lds + wave * 16384);
        constexpr int I0 = (2048 / 64) * (NIN / 32), I1 = (1024 / 64) * (1024 / 32), I2 = (1024 / 64) * (2048 / 32), I3 = I2, I4 = (2048 / 64) * (2048 / 32),
                      I5 = (2048 / 64) * (FF / 32), I6 = I5, I7 = (FF / 64) * (2048 / 32);
        (void)I1; (void)I2; (void)I3; (void)I4; (void)I5; (void)I6; (void)I7;
        for (int it = gw; it < I0; it += NGW) {
            int r = it;
            if (r < I0) { const int nb = r % (NIN / 32), kb = r / (NIN / 32);
                if (nb < 128) p0_transpose_item(A->in[1], 2048, NIN, WSP(WS_WIN), 0, scr, r, lane);
                else p0_transpose_item_fp8(A->in[1], 2048, NIN, ws + WS_WG8, 32 * nb - 4096, GATE_WSCALE, scr, 64 * kb, 32 * nb, lane);
                }
        }
        const float* x = A->in[0]; const float* wpre = A->in[20]; bf16* U = WSP(WS_U);
        for (int m = gw; m < M; m += NGW) rms_row_to_bf16(x + (size_t)m * DMOD, wpre, U + (size_t)m * DMOD, ws + WS_U8 + (size_t)m * DMOD, lane);
        if (bx == 0 && tid < 128) ((unsigned*)(ws + WS_KMAX))[tid] = 0u;
        if (bx == 1 && tid < 128) ((float*)(ws + WS_SW))[tid] = A->in[6][tid] * 0.8f;
        if (bx == 0) for (int i = tid; i < XCD_BAR_WORDS; i += NTHR) ((unsigned*)ws)[i] = 0u;
        const int gt = bx * NTHR + tid;
        if (gt < 64 * 64) ssm_param(gt >> 6, gt & 63, A->in[7], A->in[8], A->in[9], A->in[10], A->in[11], A->in[12], A->in[13], (float*)(ws + WS_ABAR), WSP(WS_BF), WSP(WS_CF));
    }
    grid.sync();
    XcdBarrier xbar;
    { const KArgs A0 = kargs_now(); xbar = xcd_barrier_post((unsigned*)A0->ws, xst); }

    {
        PH_COMMON
        pg8::StaticOrder S; S.init(M, 4096, G, bx);
        pg8::Gemm g{WSP(WS_U), WSP(WS_WIN), M, 4096, 2048};
        epi::InProj E{(unsigned*)(ws + WS_KMAX), WSP(WS_Q), WSP(WS_GA), attn_body::C2, 0, 1.f};
        pg8::gemm_phase<epi::InProj, pg8::StaticOrder, true, true>(lds, g, S, E);
    }
    {
        PH_COMMON
        pg8::StaticOrder S; S.init(M, 4096, G, bx);
        pg8::Gemm g{(const bf16*)(ws + WS_U8), (const bf16*)(ws + WS_WG8), M, 4096, 1024};
        epi::InProj E{nullptr, WSP(WS_Q), WSP(WS_GA), attn_body::C2, 4096, 1.f / GATE_WSCALE};
        pg8::gemm_phase<epi::InProj, pg8::StaticOrder, true, true, true>(lds, g, S, E);
    }
    xcd_barrier(xbar);

    {
        PH_COMMON
        ssm_phase(lds, WSP(WS_SIN), (const float*)(ws + WS_ABAR), WSP(WS_BF), WSP(WS_CF), A->in[14], WSP(WS_YS), wave, lane, G);
    }
    {
        PH_COMMON
        const float d1 = wave_sum(A->in[2][lane] * A->in[3][lane]), d2 = wave_sum(A->in[4][lane] * A->in[5][lane]);
        const float lam = __uint_as_float(__builtin_amdgcn_readfirstlane(__float_as_uint(__expf(d1) - __expf(d2) + 0.2f)));
        static_assert(AWS_Q == WS_Q && AWS_K == WS_K && AWS_V == WS_V && AWS_OLO == WS_OLO && AWS_OHI == WS_OHI && AWS_YA == WS_YA && AWS_SW == WS_SW, "attention body offsets vs d_ws map");
        for (int w = vcu; w < 256; w += G) {
            const int bhd = w >> 3, s = w & 7, b = bhd >> 3, hd = bhd & 7;
            for (int j = 0; j < 4; ++j) { const int qb = (j == 0) ? s : (j == 1) ? 15 - s : (j == 2) ? 16 + s : 31 - s;
#pragma unroll 1
                for (int cmap = 0; cmap < 2; ++cmap) { const int hh = 2 * hd + cmap, bh = b * 16 + hh;
                    const float kmax = 1.01f * sqrtf(__uint_as_float(__builtin_amdgcn_readfirstlane(__hip_atomic_load((unsigned*)(ws + WS_KMAX) + 2 * bh, __ATOMIC_RELAXED, __HIP_MEMORY_SCOPE_AGENT)))
                                                   + __uint_as_float(__builtin_amdgcn_readfirstlane(__hip_atomic_load((unsigned*)(ws + WS_KMAX) + 2 * bh + 1, __ATOMIC_RELAXED, __HIP_MEMORY_SCOPE_AGENT))));
                    attn_body::attn_unit<8>(b, hh, qb, ws, (char*)lds_raw, kmax, cmap, lam);
                    if (2 * j + cmap == (vcu & 7)) deferred_weight_copies(); } }
        }
    }
    xcd_barrier(xbar);

    {
        PH_COMMON
        pg8::Gemm g{WSP(WS_YS), WSP(WS_WGLU), M, 1024, 1024}; pg8::StaticOrder S; S.init(M, 1024, G, bx);
        epi::Ew<2> E{WSP(WS_YA) + 1024, 2048, WSP(WS_YS), nullptr, A->in[16], 1024};
        pg8::gemm_phase<epi::Ew<2>, pg8::StaticOrder, true, true>(lds, g, S, E);
    }
    xcd_barrier(xbar);

    {
        PH_COMMON
        pg8::Gemm g{WSP(WS_YA), WSP(WS_WA), M, 2048, 2048}; pg8::StaticOrder S; S.init(M, 2048, G, bx);
        epi::Gated E{WSP(WS_MERGED), 2048, WSP(WS_GA), WSP(WS_GS)};
        pg8::gemm_phase<epi::Gated, pg8::StaticOrder, true, true>(lds, g, S, E);
    }
    xcd_barrier(xbar);
    {
        PH_COMMON
        pg8::Gemm g{WSP(WS_MERGED), WSP(WS_WOUT), M, 2048, 2048}; pg8::StaticOrder S; S.init(M, 2048, G, bx);
        epi::Ew<0> E{WSP(WS_MIX), 2048, nullptr, nullptr, nullptr, 0};
        pg8::gemm_phase<epi::Ew<0>, pg8::StaticOrder, true, true>(lds, g, S, E);
    }
    xcd_barrier(xbar);
    {
        PH_COMMON
        bf16* Z = WSP(WS_U); const bf16* MIX = WSP(WS_MIX); const float* x = A->in[0]; const float* wpost = A->in[21]; const float* wpre2 = A->in[25];
        for (int m = gw; m < M; m += NGW) {
            const f32x4* xr = (const f32x4*)(x + (size_t)m * DMOD) + lane; const u32x2v* mr = (const u32x2v*)(MIX + (size_t)m * DMOD) + lane;
            f32x4 xv[8], mv[8]; float ss = 0.f;
#pragma unroll
            for (int j = 0; j < 8; ++j) { xv[j] = xr[64 * j]; const u32x2v w = mr[64 * j]; mv[j] = (f32x4){bf_lo(w.x), bf_hi(w.x), bf_lo(w.y), bf_hi(w.y)};
                ss += (mv[j].x * mv[j].x + mv[j].y * mv[j].y) + (mv[j].z * mv[j].z + mv[j].w * mv[j].w); }
            const float r1 = 1.0f / sqrtf(wave_sum(ss) * (1.f / DMOD) + EPS); float s2 = 0.f;
#pragma unroll
            for (int j = 0; j < 8; ++j) { const f32x4 w1 = ((const f32x4*)wpost)[lane + 64 * j]; xv[j] = xv[j] + mv[j] * r1 * w1;
                s2 += (xv[j].x * xv[j].x + xv[j].y * xv[j].y) + (xv[j].z * xv[j].z + xv[j].w * xv[j].w); }
            const float r2 = 1.0f / sqrtf(wave_sum(s2) * (1.f / DMOD) + EPS);
            u32x2v* zr = (u32x2v*)(Z + (size_t)m * DMOD) + lane;
#pragma unroll
            for (int j = 0; j < 8; ++j) { const f32x4 w2 = ((const f32x4*)wpre2)[lane + 64 * j]; const f32x4 y = xv[j] * r2 * w2; u32x2v o; o.x = pkbf(y.x, y.y); o.y = pkbf(y.z, y.w); zr[64 * j] = o; }
        }
    }
    xcd_barrier(xbar);
    {
        PH_COMMON
        pg8::Gemm g{WSP(WS_U), WSP(WS_WGU), M, NGU, 2048}; pg8::StaticOrder S; S.init(M, NGU, G, bx);
        epi::SwiGlu E{ws + WS_ACT, ACT_PITCH, FFN_H8, ACT_S8};
        pg8::gemm_phase<epi::SwiGlu, pg8::StaticOrder, true, true>(lds, g, S, E);
    }
    xcd_barrier(xbar);
    {
        PH_COMMON
        pg8::Gemm g{WSP(WS_ACT), WSP(WS_WD), M, 2048, ACT_PITCH / 2, FFN_T8}; pg8::StaticOrder S; S.init(M, 2048, G, bx);
        epi::PlainMix E{WSP(WS_F), 2048, FFN_T8, 1.f / (ACT_S8 * WD_S8)};
        pg8::gemm_phase<epi::PlainMix, pg8::StaticOrder, true, true, false, true>(lds, g, S, E);
    }
    xcd_barrier(xbar);
    {
        PH_COMMON
        float* out = A->out; const float* x = A->in[0]; const bf16* MIX = WSP(WS_MIX); const bf16* Fb = WSP(WS_F); const float* wpost = A->in[21]; const float* wpost2 = A->in[26];
        for (int m = gw; m < M; m += NGW) {
            const f32x4* xr = (const f32x4*)(x + (size_t)m * DMOD) + lane; const u32x2v* mr = (const u32x2v*)(MIX + (size_t)m * DMOD) + lane; const u32x2v* fr = (const u32x2v*)(Fb + (size_t)m * DMOD) + lane;
            f32x4 xv[8], mv[8], fv[8]; float ss = 0.f, sf = 0.f;
#pragma unroll
            for (int j = 0; j < 8; ++j) { xv[j] = xr[64 * j]; const u32x2v w = mr[64 * j]; mv[j] = (f32x4){bf_lo(w.x), bf_hi(w.x), bf_lo(w.y), bf_hi(w.y)};
                const u32x2v wf = fr[64 * j]; fv[j] = (f32x4){bf_lo(wf.x), bf_hi(wf.x), bf_lo(wf.y), bf_hi(wf.y)};
                ss += (mv[j].x * mv[j].x + mv[j].y * mv[j].y) + (mv[j].z * mv[j].z + mv[j].w * mv[j].w);
                sf += (fv[j].x * fv[j].x + fv[j].y * fv[j].y) + (fv[j].z * fv[j].z + fv[j].w * fv[j].w); }
            const float r1 = 1.0f / sqrtf(wave_sum(ss) * (1.f / DMOD) + EPS), r3 = 1.0f / sqrtf(wave_sum(sf) * (1.f / DMOD) + EPS);
            f32x4* orow = (f32x4*)(out + (size_t)m * DMOD) + lane;
#pragma unroll
            for (int j = 0; j < 8; ++j) { const f32x4 w1 = ((const f32x4*)wpost)[lane + 64 * j], w3 = ((const f32x4*)wpost2)[lane + 64 * j];
                const f32x4 h = xv[j] + mv[j] * r1 * w1; orow[64 * j] = h + fv[j] * r3 * w3; }
        }
    }
}

extern "C" void kernel_launch(void* const* d_in, const int* in_sizes, int n_in, void* d_out, int out_size, void* d_ws, size_t ws_size, hipStream_t stream) {
    static int grid = 0;
    if (grid == 0) {
        if (n_in != 27 || in_sizes[0] != M * DMOD || out_size != M * DMOD || ws_size < WS_END) {
            fprintf(stderr, "kernel_launch: unexpected shapes: n_in %d in0 %d out %d ws %zu (need %zu)\n", n_in, n_in > 0 ? in_sizes[0] : -1, out_size, ws_size, (size_t)WS_END); grid = -1; return; }
        int dev = 0, cus = 0, per_cu = 0;
        (void)hipGetDevice(&dev); (void)hipDeviceGetAttribute(&cus, hipDeviceAttributeMultiprocessorCount, dev);
        if (hipFuncSetAttribute((const void*)fwd_megakernel, hipFuncAttributeMaxDynamicSharedMemorySize, LDS_BYTES) != hipSuccess) { fprintf(stderr, "kernel_launch: hipFuncSetAttribute failed\n"); grid = -1; return; }
        if (hipOccupancyMaxActiveBlocksPerMultiprocessor(&per_cu, (const void*)fwd_megakernel, NTHR, LDS_BYTES) != hipSuccess || per_cu < 1) { fprintf(stderr, "kernel_launch: occupancy query says %d\n", per_cu); per_cu = 1; }
        (void)hipGetLastError();
        grid = cus * per_cu;
    }
    if (grid < 0) return;
    Args a{};
    for (int i = 0; i < 27; ++i) a.in[i] = (const float*)d_in[i];
    a.out = (float*)d_out; a.ws = (unsigned char*)d_ws;
    void* kargs[] = {&a};
    const hipError_t e = hipLaunchCooperativeKernel((const void*)fwd_megakernel, dim3(grid), dim3(NTHR), kargs, LDS_BYTES, stream);
    if (e != hipSuccess) fprintf(stderr, "kernel_launch: cooperative launch failed: %s (grid %d)\n", hipGetErrorString(e), grid);
}
```

```cpp
#include <hip/hip_runtime.h>
#include <cstdio>
#include <cstdint>
constexpr size_t AWS_Q = 256ull << 20, AWS_K = 320ull << 20, AWS_V = 384ull << 20, AWS_OLO = 768ull << 20, AWS_OHI = 832ull << 20, AWS_YA = 128ull << 20, AWS_SW = 768 * 1024;
__device__ __forceinline__ int tid_now() { int t = threadIdx.x; asm volatile("" : "+v"(t)); return t; }
namespace pg8 {
#define PG8_LAS __attribute__((address_space(3)))
typedef unsigned short bf16_t;
typedef short bf16x8 __attribute__((ext_vector_type(8)));
typedef float f32x4 __attribute__((ext_vector_type(4)));
typedef unsigned u32x4 __attribute__((ext_vector_type(4)));
constexpr int BM = 256, BK = 64, HALF = 128, HTB = HALF * BK * 2  , STAGE_BYTES = 8 * HTB, NXCD = 8, WGM = 8;

__host__ __device__ __forceinline__ int lds_byte(int r, int c) { const int st = (r >> 4) * 2 + (c >> 5), rr = r & 15, cc = c & 31, ob = rr * 64 + cc * 2; return st * 1024 + (ob ^ (((ob >> 9) & 1) << 5)); }
__host__ __device__ __forceinline__ void stage_rc(int b, int& R, int& C) { const int st = b / 1024, sb = b % 1024, swz = sb ^ (((sb >> 9) & 1) << 5); R = (st >> 1) * 16 + swz / 64; C = (st & 1) * 32 + (swz % 64) / 2; }
__host__ __device__ __forceinline__ int perm32(int rho) { const int n = rho >> 4, i = rho & 15; return 8 * (i >> 2) + 4 * n + (i & 3); }

struct Unit { int pm, pn; };
struct Gemm { const bf16_t* A; const bf16_t* Bt; int M, N, K; int t8 = 0; };

struct StaticOrder {
    int nM, nN, nwg, G, c;
    __host__ __device__ void init(int M, int N, int G_, int c_) { nM = M / BM; nN = N / BM; nwg = nM * nN; G = G_; c = c_; }
    __host__ __device__ bool next(int i, Unit& u) const {
        const long L = (long)i * G + c; if (L >= nwg) return false;
        int wgid = (int)L; { const int q = nwg / NXCD, r = nwg % NXCD, xcd = wgid % NXCD, off = wgid / NXCD; wgid = (xcd < r ? xcd * (q + 1) : r * (q + 1) + (xcd - r) * q) + off; }
        const int nig = WGM * nN, gid = wgid / nig, fm = gid * WGM, gsz = (nM - fm) < WGM ? (nM - fm) : WGM;
        u.pm = fm + ((wgid % nig) % gsz); u.pn = (wgid % nig) / gsz; return true;
    }
    __device__ __forceinline__ void a_ready(const Unit&) const {}
    __device__ __forceinline__ void done(const Unit&) const {}
};

__device__ __forceinline__ unsigned cvt_pk_bf16(float lo, float hi) { unsigned r; asm volatile("v_cvt_pk_bf16_f32 %0, %1, %2" : "=v"(r) : "v"(lo), "v"(hi)); return r; }
typedef float f32x2 __attribute__((ext_vector_type(2)));
__device__ __forceinline__ f32x2 gelu_pk(f32x2 v) {
    const f32x2 av = __builtin_elementwise_abs(v), d = av * 0.2316418882f + 1.0f;
    f32x2 t; t.x = __builtin_amdgcn_rcpf(d.x); t.y = __builtin_amdgcn_rcpf(d.y);
    f32x2 q = t * 0.5307027145f + (-0.7265760135f); q = q * t + 0.7107068705f; q = q * t + (-0.142248368f); q = q * t + 0.127414796f; q = q * t;
    const f32x2 s = (v * v) * (-0.72134752044f);
    f32x2 e; e.x = __builtin_amdgcn_exp2f(s.x); e.y = __builtin_amdgcn_exp2f(s.y);
    const f32x2 m = v * (q * e), r = v - m;
    f32x2 o; o.x = v.x < 0.f ? m.x : r.x; o.y = v.y < 0.f ? m.y : r.y; return o;
}

template <int ACT  > struct EpiBf16 {
    static constexpr bool PERM = true, AFTER_DRAIN = false, MID_HOOK = false; static_assert(ACT == 0 || ACT == 1, "EpiBf16: ACT is 0 (none) or 1 (gelu_pk)");
    bf16_t* O; int ldc; const float* bias; int split_cols; size_t split_stride; float scale0;
    __device__ __forceinline__ void operator()(const f32x4 (&acc)[2][2][4][2], const Unit& u, int wr, int wc, int fr, int fq) const {
        const int row0 = u.pm * BM + wr * 64 + fr; int colt = u.pn * BM; bf16_t* base = O;
        float sc = 1.f; if (split_cols) { const int t = colt / split_cols; base += (size_t)t * split_stride; colt -= t * split_cols; if (t == 0) sc = scale0; }
        const int col0 = colt + wc * 32 + 8 * fq, bcol0 = u.pn * BM + wc * 32 + 8 * fq;
        f32x4 bv[2][2];
#pragma unroll
        for (int bj = 0; bj < 2; ++bj)
#pragma unroll
            for (int n = 0; n < 2; ++n) bv[bj][n] = bias ? *(const f32x4*)(bias + bcol0 + bj * HALF + 4 * n) : (f32x4){0.f, 0.f, 0.f, 0.f};
#pragma unroll
        for (int ai = 0; ai < 2; ++ai)
#pragma unroll
            for (int m = 0; m < 4; ++m) { bf16_t* rowp = base + (size_t)(row0 + ai * HALF + m * 16) * ldc + col0;
#pragma unroll
                for (int bj = 0; bj < 2; ++bj) { f32x4 v0 = acc[ai][bj][m][0] + bv[bj][0], v1 = acc[ai][bj][m][1] + bv[bj][1];
                    if (ACT == 1) { f32x2 a = gelu_pk((f32x2){v0[0], v0[1]}), b = gelu_pk((f32x2){v0[2], v0[3]}), c = gelu_pk((f32x2){v1[0], v1[1]}), d = gelu_pk((f32x2){v1[2], v1[3]});
                        v0 = (f32x4){a.x, a.y, b.x, b.y}; v1 = (f32x4){c.x, c.y, d.x, d.y}; }
                    v0 = v0 * sc; v1 = v1 * sc; u32x4 w; w.x = cvt_pk_bf16(v0[0], v0[1]); w.y = cvt_pk_bf16(v0[2], v0[3]); w.z = cvt_pk_bf16(v1[0], v1[1]); w.w = cvt_pk_bf16(v1[2], v1[3]);
                    *(u32x4*)(rowp + bj * HALF) = w; } }
    }
};


template <class Epi, class Sched, bool ALIGN_EPI = false, bool SP2 = false, bool FP8 = false, bool MIX8 = false>
__device__ __forceinline__ void gemm_phase(PG8_LAS unsigned char* lds, const Gemm g, const Sched& S, const Epi& E) {
    const int tid = tid_now(), wid = __builtin_amdgcn_readfirstlane(tid >> 6), lane = tid & 63, wr = wid >> 2, wc = wid & 3, fr = lane & 15, fq = lane >> 4;
    const int K = g.K, nt = K / BK;
    unsigned voffA[2], voffB[2];
#pragma unroll
    for (int i = 0; i < 2; ++i) { int R, C; stage_rc(tid * 16 + i * 8192, R, C); const int Rb = Epi::PERM ? ((R & ~31) + perm32(R & 31)) : R;
        voffA[i] = (unsigned)(R * K + C) * 2u; voffB[i] = (unsigned)(Rb * K + C) * 2u; }
    const size_t kstep = (size_t)(BK * 2);
    const size_t hstep = (size_t)HALF * K * 2;
    const size_t tstep = 2 * hstep;
    const unsigned ldsw = (unsigned)wid * 1024u;
    const int aoff = lds_byte(wr * 64 + fr, fq * 8), boff = lds_byte(wc * 32 + fr, fq * 8);
#define PG8_SA(b, h) (((b) * 2 + (h)) * HTB)
#define PG8_SB(b, h) ((4 + (b) * 2 + (h)) * HTB)
#define PG8_STAGE(bufoff, gbase, voff) do { _Pragma("unroll") for (int _i = 0; _i < 2; ++_i) \
        __builtin_amdgcn_global_load_lds((const unsigned*)((const char*)(gbase) + (voff)[_i]), (PG8_LAS unsigned*)(lds + (bufoff) + ldsw + _i * 8192), 16, 0, 0); } while (0)
#define PG8_LDA(dst, b, h) do { _Pragma("unroll") for (int m = 0; m < 4; ++m) _Pragma("unroll") for (int k = 0; k < 2; ++k) dst[m][k] = *(const PG8_LAS bf16x8*)(lds + PG8_SA(b, h) + aoff + m * 2048 + k * 1024); } while (0)
#define PG8_LDB(dst, b, h) do { _Pragma("unroll") for (int n = 0; n < 2; ++n) _Pragma("unroll") for (int k = 0; k < 2; ++k) dst[n][k] = *(const PG8_LAS bf16x8*)(lds + PG8_SB(b, h) + boff + n * 2048 + k * 1024); } while (0)
#define PG8_MMA_F8(ai, bj, At, Bt) do { __builtin_amdgcn_s_setprio(1); { typedef int v4i_ __attribute__((ext_vector_type(4))); typedef int v8i_ __attribute__((ext_vector_type(8))); \
            _Pragma("unroll") for (int m = 0; m < 4; ++m) _Pragma("unroll") for (int n = 0; n < 2; ++n) \
                { const v8i_ b8_ = __builtin_shufflevector(__builtin_bit_cast(v4i_, Bt[n][0]), __builtin_bit_cast(v4i_, Bt[n][1]), 0, 1, 2, 3, 4, 5, 6, 7), \
                             a8_ = __builtin_shufflevector(__builtin_bit_cast(v4i_, At[m][0]), __builtin_bit_cast(v4i_, At[m][1]), 0, 1, 2, 3, 4, 5, 6, 7); \
                  asm volatile("v_mfma_scale_f32_16x16x128_f8f6f4 %0, %1, %2, %0, %3, %3 op_sel_hi:[0,0,0]" : "+v"(acc[ai][bj][m][n]) : "v"(b8_), "v"(a8_), "v"(0x7f7f7f7f)); }     \
        } __builtin_amdgcn_s_setprio(0); } while (0)
#define PG8_MMA_BF(ai, bj, At, Bt) do { __builtin_amdgcn_s_setprio(1); _Pragma("unroll") for (int m = 0; m < 4; ++m) _Pragma("unroll") for (int n = 0; n < 2; ++n) _Pragma("unroll") for (int k = 0; k < 2; ++k) \
        acc[ai][bj][m][n] = __builtin_amdgcn_mfma_f32_16x16x32_bf16(Bt[n][k], At[m][k], acc[ai][bj][m][n], 0, 0, 0); __builtin_amdgcn_s_setprio(0); } while (0)
#define PG8_MMA_BFA(ai, bj, At, Bt) do { __builtin_amdgcn_s_setprio(1); _Pragma("unroll") for (int k = 0; k < 2; ++k) _Pragma("unroll") for (int m = 0; m < 4; ++m) _Pragma("unroll") for (int n = 0; n < 2; ++n) \
        asm volatile("v_mfma_f32_16x16x32_bf16 %0, %1, %2, %0" : "+v"(acc[ai][bj][m][n]) : "v"(Bt[n][k]), "v"(At[m][k])); __builtin_amdgcn_s_setprio(0); } while (0)
#define PG8_MMA(ai, bj, At, Bt) do { if constexpr (FP8) PG8_MMA_F8(ai, bj, At, Bt); else PG8_MMA_BF(ai, bj, At, Bt); } while (0)
#define PG8_SP2_BODY(MM) do { \
            PG8_LDB(B0, 0, 0); PG8_LDB(B1, 0, 1); PG8_SCHED; PG8_LDA(At, 0, 0); PG8_STAGE(PG8_SA(1, 1), a1 + hstep, voffA); \
            PG8_WAIT_V(8); PG8_WAIT_L(0); PG8_BAR; MM(0, 0, At, B0); MM(0, 1, At, B1); PG8_BAR; PG8_SCHED; \
            PG8_LDA(At, 0, 1); PG8_STAGE(PG8_SB(0, 0), b2, voffB); PG8_STAGE(PG8_SB(0, 1), b2 + hstep, voffB); PG8_STAGE(PG8_SA(0, 0), a2, voffA); \
            PG8_WAIT_V(8); PG8_WAIT_L(0); PG8_BAR; MM(1, 0, At, B0); MM(1, 1, At, B1); PG8_BAR; PG8_SCHED; \
            PG8_LDB(B0, 1, 0); PG8_LDB(B1, 1, 1); PG8_SCHED; PG8_LDA(At, 1, 0); PG8_STAGE(PG8_SA(0, 1), a2 + hstep, voffA); \
            PG8_WAIT_V(8); PG8_WAIT_L(0); PG8_BAR; MM(0, 0, At, B0); MM(0, 1, At, B1); PG8_BAR; PG8_SCHED; \
            PG8_LDA(At, 1, 1); PG8_STAGE(PG8_SB(1, 0), b3, voffB); PG8_STAGE(PG8_SB(1, 1), b3 + hstep, voffB); PG8_STAGE(PG8_SA(1, 0), a3, voffA); \
            PG8_WAIT_V(8); PG8_WAIT_L(0); PG8_BAR; MM(1, 0, At, B0); MM(1, 1, At, B1); PG8_BAR; PG8_SCHED; \
            } while (0)
#define PG8_WAIT_V(n) asm volatile("s_waitcnt vmcnt(" #n ")" ::: "memory")
#define PG8_WAIT_L(n) asm volatile("s_waitcnt lgkmcnt(" #n ")" ::: "memory")
#define PG8_BAR __builtin_amdgcn_s_barrier()
#define PG8_SCHED __builtin_amdgcn_sched_barrier(0)
    Unit cur, nxt; int ui = 0;
    if (!S.next(0, cur)) return;
    f32x4 acc[2][2][4][2];
#pragma unroll
    for (int a = 0; a < 2; ++a)
#pragma unroll
        for (int b = 0; b < 2; ++b)
#pragma unroll
            for (int m = 0; m < 4; ++m)
#pragma unroll
                for (int n = 0; n < 2; ++n) acc[a][b][m][n] = (f32x4){0.f, 0.f, 0.f, 0.f};
    bf16x8 At[4][2], B0[2][2], B1[2][2];
    const char* cA = (const char*)g.A + (size_t)cur.pm * tstep; const char* cB = (const char*)g.Bt + (size_t)cur.pn * tstep;
    S.a_ready(cur);
    if constexpr (SP2) {
        PG8_STAGE(PG8_SB(0, 0), cB, voffB); PG8_STAGE(PG8_SB(0, 1), cB + hstep, voffB); PG8_STAGE(PG8_SA(0, 0), cA, voffA); PG8_STAGE(PG8_SA(0, 1), cA + hstep, voffA);
        if (wr == 1) PG8_BAR;
        PG8_WAIT_V(2); PG8_BAR;
        PG8_STAGE(PG8_SB(1, 0), cB + kstep, voffB); PG8_STAGE(PG8_SA(1, 0), cA + kstep, voffA); PG8_STAGE(PG8_SB(1, 1), cB + hstep + kstep, voffB);
        PG8_WAIT_V(6); PG8_BAR;
    } else {
        PG8_STAGE(PG8_SB(0, 0), cB, voffB); PG8_STAGE(PG8_SA(0, 0), cA, voffA); PG8_STAGE(PG8_SB(0, 1), cB + hstep, voffB); PG8_STAGE(PG8_SA(0, 1), cA + hstep, voffA);
        if (wr == 1) PG8_BAR;
        PG8_WAIT_V(4); PG8_BAR;
        PG8_STAGE(PG8_SB(1, 0), cB + kstep, voffB); PG8_STAGE(PG8_SA(1, 0), cA + kstep, voffA); PG8_STAGE(PG8_SB(1, 1), cB + hstep + kstep, voffB);
        PG8_WAIT_V(6); PG8_BAR;
    }
    for (;;) {
        const bool has_next = S.next(ui + 1, nxt);
        const char* nA = has_next ? (const char*)g.A + (size_t)nxt.pm * tstep : cA; const char* nB = has_next ? (const char*)g.Bt + (size_t)nxt.pn * tstep : cB;
#define PG8_TRIP(MM) { const bool last = (t == nt - 2); const char* a1 = cA + (size_t)(t + 1) * kstep; \
            const char* a2 = last ? nA : cA + (size_t)(t + 2) * kstep; const char* b2 = last ? nB : cB + (size_t)(t + 2) * kstep; const char* a3 = a2 + kstep; const char* b3 = b2 + kstep; \
            if (last && has_next) S.a_ready(nxt); PG8_SP2_BODY(MM); }
        if constexpr (MIX8) {
            static_assert(SP2 && Epi::MID_HOOK, "MIX8 is written for the SP2 loop with a mid-K hook");
            int t = 0;
            for (; t < g.t8; t += 2) PG8_TRIP(PG8_MMA_F8)
            asm volatile("s_nop 15\n\ts_nop 15\n\ts_nop 15" ::: "memory");
            E.mid(acc, cur, wr, wc, fr, fq);
            for (; t < nt; t += 2) PG8_TRIP(PG8_MMA_BF)
        } else
        for (int t = 0; t < nt; t += 2) {
            const bool last = (t == nt - 2);
            if constexpr (Epi::MID_HOOK) { if (t == E.mid_t(nt)) { if constexpr (FP8) asm volatile("s_nop 15\n\ts_nop 15\n\ts_nop 15" ::: "memory");
                E.mid(acc, cur, wr, wc, fr, fq); } }
            const char* a1 = cA + (size_t)(t + 1) * kstep;
            const char* a2 = last ? nA : cA + (size_t)(t + 2) * kstep; const char* b2 = last ? nB : cB + (size_t)(t + 2) * kstep;
            const char* a3 = a2 + kstep; const char* b3 = b2 + kstep;
            if (last && has_next) S.a_ready(nxt);
            if constexpr (SP2) {
            if constexpr (FP8) PG8_SP2_BODY(PG8_MMA_F8); else PG8_SP2_BODY(PG8_MMA_BF);
            } else {
            PG8_LDB(B0, 0, 0); PG8_SCHED; PG8_LDA(At, 0, 0); PG8_STAGE(PG8_SA(1, 1), a1 + hstep, voffA);
            PG8_WAIT_L(8); PG8_BAR; PG8_WAIT_L(0); PG8_MMA(0, 0, At, B0); PG8_BAR; PG8_SCHED;
            PG8_LDB(B1, 0, 1); PG8_STAGE(PG8_SB(0, 0), b2, voffB);
            PG8_BAR; PG8_WAIT_L(0); PG8_MMA(0, 1, At, B1); PG8_BAR;
            PG8_LDA(At, 0, 1); PG8_STAGE(PG8_SA(0, 0), a2, voffA);
            PG8_BAR; PG8_WAIT_L(0); PG8_MMA(1, 0, At, B0); PG8_BAR; PG8_SCHED;
            PG8_STAGE(PG8_SB(0, 1), b2 + hstep, voffB);
            PG8_WAIT_V(6); PG8_BAR; PG8_MMA(1, 1, At, B1); PG8_BAR;
            PG8_LDB(B0, 1, 0); PG8_SCHED; PG8_LDA(At, 1, 0); PG8_STAGE(PG8_SA(0, 1), a2 + hstep, voffA);
            PG8_WAIT_L(8); PG8_BAR; PG8_WAIT_L(0); PG8_MMA(0, 0, At, B0); PG8_BAR; PG8_SCHED;
            PG8_LDB(B1, 1, 1); PG8_STAGE(PG8_SB(1, 0), b3, voffB);
            PG8_BAR; PG8_WAIT_L(0); PG8_MMA(0, 1, At, B1); PG8_BAR;
            PG8_LDA(At, 1, 1); PG8_STAGE(PG8_SA(1, 0), a3, voffA);
            PG8_BAR; PG8_WAIT_L(0); PG8_MMA(1, 0, At, B0); PG8_BAR; PG8_SCHED;
            PG8_STAGE(PG8_SB(1, 1), b3 + hstep, voffB);
            PG8_WAIT_V(6); PG8_BAR; PG8_MMA(1, 1, At, B1); PG8_BAR;
            }
        }
        if constexpr (FP8 || MIX8) asm volatile("s_nop 15\n\ts_nop 15" ::: "memory");
        if constexpr (ALIGN_EPI) { if (wr == 0) PG8_BAR; }
        if constexpr (!Epi::AFTER_DRAIN) { E(acc, cur, wr, wc, fr, fq); S.done(cur); }
        if (!has_next) break;
#pragma unroll
        for (int a = 0; a < 2; ++a)
#pragma unroll
            for (int b = 0; b < 2; ++b)
#pragma unroll
                for (int m = 0; m < 4; ++m)
#pragma unroll
                    for (int n = 0; n < 2; ++n) acc[a][b][m][n] = (f32x4){0.f, 0.f, 0.f, 0.f};
        cur = nxt; cA = nA; cB = nB; ++ui;
        if constexpr (ALIGN_EPI) { if (wr == 1) PG8_BAR; }
    }
    PG8_WAIT_V(0);
    if constexpr (!ALIGN_EPI) { if (wr == 0) PG8_BAR; }
    PG8_BAR;
    if constexpr (Epi::AFTER_DRAIN) { E.fused(acc, cur, wr, wc, fr, fq, lds, wid, lane); S.done(cur); }
#undef PG8_SA
#undef PG8_SB
#undef PG8_STAGE
#undef PG8_LDA
#undef PG8_LDB
#undef PG8_MMA
#undef PG8_MMA_F8
#undef PG8_MMA_BF
#undef PG8_MMA_BFA
#undef PG8_TRIP
#undef PG8_SP2_BODY
#undef PG8_WAIT_V
#undef PG8_WAIT_L
#undef PG8_BAR
#undef PG8_SCHED
}
}

#ifndef PG8_SP2
#define PG8_SP2 true
#endif
#ifndef PG8_ALIGN
#define PG8_ALIGN true
#endif
#include <hip/hip_bf16.h>
#include <cmath>
namespace attn_body {
using bf16=__hip_bfloat16;
using bf16x8=__attribute__((ext_vector_type(8)))short;
using s16x4=__attribute__((ext_vector_type(4)))short;
using f32x16=__attribute__((ext_vector_type(16)))float;
using u32x4=__attribute__((ext_vector_type(4)))unsigned;
constexpr int BATCH=4,NHEAD=16,SEQ=8192,D=64,DM=NHEAD*D;
constexpr int NW=8,QBLK=32,QB=QBLK*NW,KVBLK=64,NQB=SEQ/QB;
constexpr int ATTN_PITCH=DM, ATTN_UNIT_ROWS=QB;
__device__ __forceinline__ int crow(int r,int hi){return (r&3)+8*(r>>2)+4*hi;}
#define SBAR() __builtin_amdgcn_sched_barrier(0)
__device__ __forceinline__ void cmask(f32x16&p0,f32x16&p1,int jb,int qrel,int hi){
  const float NEG=-INFINITY; int kb=64*jb+4*hi;
  #pragma unroll
  for(int r=0;r<16;++r){int kv=kb+(r&3)+8*(r>>2); if(kv>qrel)p0[r]=NEG; if(kv+32>qrel)p1[r]=NEG;}
}

constexpr int NSLOT=3, SLOTB=8192;
constexpr int LDS_K=0, LDS_V=NSLOT*SLOTB, LDS_V2=2*NSLOT*SLOTB, LDS_WS=3*NSLOT*SLOTB, LDS_OST=LDS_WS+NW*64*4, LDS_BYTES=LDS_OST+NW*4096;
constexpr float C2=0.125f*1.4426950408889634f;
__device__ __forceinline__ void glds16(const void*gsrc,unsigned lds_dst){unsigned keep;
  asm volatile("s_mov_b32 %0, m0\n\ts_mov_b32 m0, %2\n\ts_nop 0\n\tglobal_load_lds_dwordx4 %1, off\n\ts_mov_b32 m0, %0":"=&s"(keep):"v"(gsrc),"s"(lds_dst):"memory");}
__device__ __forceinline__ float max3f(float a,float b,float c){float r;asm("v_max3_f32 %0, %1, %2, %3":"=v"(r):"v"(a),"v"(b),"v"(c));return r;}
__device__ __forceinline__ float max2f(float a,float b){float r;asm("v_max_f32_e32 %0, %1, %2":"=v"(r):"v"(a),"v"(b));return r;}
__device__ __forceinline__ float fadd_s(float a,float b){float r;asm("v_add_f32_e32 %0, %1, %2":"=v"(r):"v"(a),"v"(b));return r;}
__device__ __forceinline__ float fsub_s(float a,float b){float r;asm("v_sub_f32_e32 %0, %1, %2":"=v"(r):"v"(a),"v"(b));return r;}
typedef float f32x2_t __attribute__((ext_vector_type(2))); typedef __bf16 bf16x2_t __attribute__((ext_vector_type(2)));
__device__ __forceinline__ unsigned cvtpk_s(float lo,float hi){f32x2_t v={lo,hi};bf16x2_t b=__builtin_convertvector(v,bf16x2_t);return __builtin_bit_cast(unsigned,b);}
#define WAIT_BAR(N) asm volatile("s_waitcnt vmcnt(" #N ") lgkmcnt(0)\n\ts_barrier":::"memory")

__device__ __forceinline__ void qkt(f32x16&p0,f32x16&p1,const char*Kslot,const bf16x8*qr,const f32x16&negm,int r32,int hi){
  const char*kb=Kslot+hi*1024+r32*16;
  #pragma unroll
  for(int d0=0;d0<4;++d0){
    const bf16x8 b0=*reinterpret_cast<const bf16x8*>(kb+d0*2048);
    const bf16x8 b1=*reinterpret_cast<const bf16x8*>(kb+d0*2048+512);
    if(d0==0){p0=__builtin_amdgcn_mfma_f32_32x32x16_bf16(b0,qr[0],negm,0,0,0);p1=__builtin_amdgcn_mfma_f32_32x32x16_bf16(b1,qr[0],negm,0,0,0);}
    else{p0=__builtin_amdgcn_mfma_f32_32x32x16_bf16(b0,qr[d0],p0,0,0,0);p1=__builtin_amdgcn_mfma_f32_32x32x16_bf16(b1,qr[d0],p1,0,0,0);}}
}
typedef __attribute__((address_space(3))) const char* lds_cptr;
typedef short v4i16_t __attribute__((ext_vector_type(4)));
__device__ __forceinline__ void kload8(bf16x8*kf,lds_cptr kp){
  kf[0]=*(const __attribute__((address_space(3))) bf16x8*)(kp);      kf[1]=*(const __attribute__((address_space(3))) bf16x8*)(kp+512);
  kf[2]=*(const __attribute__((address_space(3))) bf16x8*)(kp+2048); kf[3]=*(const __attribute__((address_space(3))) bf16x8*)(kp+2560);
  kf[4]=*(const __attribute__((address_space(3))) bf16x8*)(kp+4096); kf[5]=*(const __attribute__((address_space(3))) bf16x8*)(kp+4608);
  kf[6]=*(const __attribute__((address_space(3))) bf16x8*)(kp+6144); kf[7]=*(const __attribute__((address_space(3))) bf16x8*)(kp+6656);
}
__device__ __forceinline__ void kload2(bf16x8*kf,lds_cptr kp,int j){ kf[2*j]=*(const __attribute__((address_space(3))) bf16x8*)(kp+j*2048); kf[2*j+1]=*(const __attribute__((address_space(3))) bf16x8*)(kp+j*2048+512); }
__device__ __forceinline__ s16x4 vtr(lds_cptr p){ return __builtin_bit_cast(s16x4,__builtin_amdgcn_ds_read_tr16_b64_v4i16((__attribute__((address_space(3))) v4i16_t*)p)); }
__device__ __forceinline__ float rowmax(const f32x16&p0,const f32x16&p1){
  float a=max3f(p0[0],p0[1],p1[0]),b=max3f(p0[2],p0[3],p1[1]);a=max3f(a,p1[2],p1[3]);
  #pragma unroll
  for(int r=4;r<16;r+=4){a=max3f(a,p0[r],p0[r+1]);b=max3f(b,p0[r+2],p0[r+3]);a=max3f(a,p1[r],p1[r+1]);b=max3f(b,p1[r+2],p1[r+3]);}
  const float m=max2f(a,b);
  auto rr=__builtin_amdgcn_permlane32_swap(__float_as_uint(m),__float_as_uint(m),false,false);
  return max2f(__uint_as_float(rr[0]),__uint_as_float(rr[1]));
}
__device__ __forceinline__ void pv(f32x16*o,int vb,bf16x8 pa0,bf16x8 pa1,bf16x8 pa2,bf16x8 pa3){
  #pragma unroll
  for(int d0=0;d0<2;++d0){s16x4 lo[4],hi[4];
    #pragma unroll
    for(int ks=0;ks<4;++ks){
      asm volatile("ds_read_b64_tr_b16 %0,%1 offset:%c2":"=&v"(lo[ks]):"v"(vb),"i"(d0*4096+ks*1024):"memory");
      asm volatile("ds_read_b64_tr_b16 %0,%1 offset:%c2":"=&v"(hi[ks]):"v"(vb),"i"(d0*4096+ks*1024+512):"memory");}
    asm volatile("s_waitcnt lgkmcnt(0)":::"memory");SBAR();
    #define PK(k) (bf16x8){lo[k][0],lo[k][1],lo[k][2],lo[k][3],hi[k][0],hi[k][1],hi[k][2],hi[k][3]}
    o[d0]=__builtin_amdgcn_mfma_f32_32x32x16_bf16(pa0,PK(0),o[d0],0,0,0);
    o[d0]=__builtin_amdgcn_mfma_f32_32x32x16_bf16(pa1,PK(1),o[d0],0,0,0);
    o[d0]=__builtin_amdgcn_mfma_f32_32x32x16_bf16(pa2,PK(2),o[d0],0,0,0);
    o[d0]=__builtin_amdgcn_mfma_f32_32x32x16_bf16(pa3,PK(3),o[d0],0,0,0);
    #undef PK
  }
}

#ifndef ATTN_STORE16
#define ATTN_STORE16(p,v) (*(u32x4*)(p)=(v))
#endif
template<int THRL> __device__ __forceinline__ void attn_unit(int b,int h,int qb,unsigned char*wsb,char*shm,float kmax,const int CMB,float lam){
  const bf16*Q,*K,*V; { unsigned char*w_=wsb; asm volatile("":"+s"(w_)); Q=(const bf16*)(w_+AWS_Q); K=(const bf16*)(w_+AWS_K); V=(const bf16*)(w_+AWS_V); }
  constexpr int ya_pitch=2048;
  const int tid=tid_now(),lane=tid&63,r32=lane&31,hi=lane>>5; const int wid=__builtin_amdgcn_readfirstlane(tid>>6);
  const long rowbase=(long)b*SEQ; const int q0=qb*QB;
  const bf16*Qw=Q+(rowbase+q0+wid*QBLK)*DM+h*D;
  const bf16*Kh=K+rowbase*DM+h*D,*Vh=V+rowbase*DM+(h&~1)*D;
  const unsigned lds0=(unsigned)(uintptr_t)shm;
  float*wsf=(float*)(shm+LDS_WS)+wid*64;
  const bf16*ksrc=Kh+(long)lane*DM+wid*8;
  const bf16*vsrc=Vh+(long)(16*(wid&3)+(lane>>2))*DM+(wid>>2)*32+(lane&3)*8;
  const unsigned kdst=lds0+LDS_K+wid*1024, vdst=lds0+LDS_V+wid*1024, vdst2=lds0+LDS_V2+wid*1024;
  #define DMA_K(t,slot) glds16(ksrc+(long)(t)*KVBLK*DM,(unsigned)__builtin_amdgcn_readfirstlane(kdst+(slot)))
  #define DMA_V(t,slot) do{ glds16(vsrc+(long)(t)*KVBLK*DM,(unsigned)__builtin_amdgcn_readfirstlane(vdst+(slot))); glds16(vsrc+64+(long)(t)*KVBLK*DM,(unsigned)__builtin_amdgcn_readfirstlane(vdst2+(slot))); }while(0)
  const int vb0=(int)(lds0+LDS_V)+((lane>>4)&1)*32+(lane&3)*8+(4*hi+((lane&15)>>2))*64;
  const char*Kbase=shm+LDS_K; bf16x8 kf[8];
  const lds_cptr shm3=(lds_cptr)shm; const lds_cptr kp0=shm3+LDS_K+hi*1024+r32*16; const lds_cptr vp0=shm3+LDS_V+((lane>>4)&1)*32+(lane&3)*8+(4*hi+((lane&15)>>2))*64;
  const int NT=(q0+QB)/KVBLK;
  DMA_K(0,0);DMA_V(0,0);DMA_K(1,SLOTB);
  bf16x8 qr[4];
  #pragma unroll
  for(int d0=0;d0<4;++d0)qr[d0]=*reinterpret_cast<const bf16x8*>(&Qw[(long)r32*DM+d0*16+hi*8]);
  float q2_=0.f;
  #pragma unroll
  for(int d0=0;d0<4;++d0){const u32x4 w_=__builtin_bit_cast(u32x4,qr[d0]);
    #pragma unroll
    for(int e=0;e<4;++e){const float lo_=__uint_as_float(w_[e]<<16),hi_=__uint_as_float(w_[e]&0xffff0000u);q2_+=lo_*lo_+hi_*hi_;}}
  {auto rr=__builtin_amdgcn_permlane32_swap(__float_as_uint(q2_),__float_as_uint(q2_),false,false);q2_=__uint_as_float(rr[0])+__uint_as_float(rr[1]);}
  const float mhat=sqrtf(q2_)*kmax*1.004f+0.02f;
  float l_reg=0.f;f32x16 o[2];o[0]=f32x16{};o[1]=f32x16{};f32x16 o2[2];o2[0]=f32x16{};o2[1]=f32x16{};const f32x16 negm=f32x16{};
  const int qrel=wid*QBLK+r32;
  #define CMASK(P0,P1,t) do{int jb_=(t)-(NT-4); if(jb_>=0)cmask(P0,P1,jb_,qrel,hi);}while(0)
  bool resc=false;
  #define START(P0,P1) do{ resc=false; \
    { _Pragma("unroll") for(int r=0;r<16;++r){P0[r]=fsub_s(P0[r],mhat);P1[r]=fsub_s(P1[r],mhat);} \
      } \
    _Pragma("unroll") for(int r=0;r<16;++r)P0[r]=__builtin_amdgcn_exp2f(P0[r]); }while(0)
  #define RESC() do{ if(resc){ asm volatile("s_waitcnt lgkmcnt(0)":::"memory"); \
      _Pragma("unroll") for(int d_=0;d_<2;++d_) _Pragma("unroll") for(int r=0;r<16;++r){const float f_=wsf[crow(r,hi)];o[d_][r]*=f_;o2[d_][r]*=f_;} } }while(0)
  f32x16 pA0,pA1,pB0,pB1;
  int sl_prev=0,sl_cur=0,sl_next=SLOTB;
  #define ROT() do{sl_prev=sl_cur;sl_cur=sl_next;sl_next=(sl_next==(NSLOT-1)*SLOTB)?0:sl_next+SLOTB;}while(0)
  DMA_K(2,2*SLOTB);
  WAIT_BAR(4);
  qkt(pA0,pA1,Kbase,qr,negm,r32,hi);asm volatile("s_nop 15\n\ts_nop 7":"+v"(pA0),"+v"(pA1));CMASK(pA0,pA1,0);
  START(pA0,pA1);
  _Pragma("unroll") for(int r=0;r<16;++r)pA1[r]=__builtin_amdgcn_exp2f(pA1[r]);
  WAIT_BAR(0);
  DMA_K(3,0);DMA_V(1,SLOTB);
  ROT();
  kload8(kf,kp0+sl_cur);
  WAIT_BAR(3);
  s16x4 vlo[8],vhi[8],v2lo[8],v2hi[8]; u32x4 pw0,pw1,pw2,pw3;
  #define PKW(P,B) cvtpk_s(P[B],P[B+1])
  #define PAF(k) __builtin_bit_cast(bf16x8,pw##k)
  #define VFR(i) (bf16x8){vlo[i][0],vlo[i][1],vlo[i][2],vlo[i][3],vhi[i][0],vhi[i][1],vhi[i][2],vhi[i][3]}
  #define PIN(x) asm volatile("":"+v"(x))
  #define MX3(a,b,c) __builtin_fmaxf(__builtin_fmaxf((a),(b)),(c))
  #define GAPA(MF,A0,A1,A2,A3,W0,W1,PW) do{ MF; sacc+=A0; sacc+=A1; sacc+=A2; sacc+=A3; PIN(sacc); W0; W1; PIN(PW); SBAR(); }while(0)
  #define EX(v) __builtin_amdgcn_exp2f(v)
  #define GAPB(MF,X,B) do{ MF; X[B]=EX(X[B]-mhat); X[B+1]=EX(X[B+1]-mhat); X[B+2]=EX(X[B+2]-mhat); X[B+3]=EX(X[B+3]-mhat); PIN(X); SBAR(); }while(0)
  #define GAPB2(MF,X,B) do{ MF; X[B]=EX(X[B]-mhat); X[B+1]=EX(X[B+1]-mhat); PIN(X); SBAR(); }while(0)
  #define VRD2(i) do{ v2lo[i]=vtr(vp2_+(((i)>>2)*4096+((i)&3)*1024)); v2hi[i]=vtr(vp2_+(((i)>>2)*4096+((i)&3)*1024+512)); }while(0)
  #define V2FR(i) (bf16x8){v2lo[i][0],v2lo[i][1],v2lo[i][2],v2lo[i][3],v2hi[i][0],v2hi[i][1],v2hi[i][2],v2hi[i][3]}
  #define VRD(i) do{ vlo[i]=vtr(vp_+(((i)>>2)*4096+((i)&3)*1024)); vhi[i]=vtr(vp_+(((i)>>2)*4096+((i)&3)*1024+512)); }while(0)
  #define KRD(G,j) do{ if(G){ kload2(kf,kp0+sl_next,j); SBAR(); } }while(0)
  #define STEP(C0,C1,P0,P1,t,GK,GV,GL) do{ SBAR(); \
    const lds_cptr vp_=vp0+sl_prev; \
    VRD(0); SBAR(); float sacc=(P0[0]+P0[1]); \
    GAPA(C0=__builtin_amdgcn_mfma_f32_32x32x16_bf16(kf[0],qr[0],negm,0,0,0), P0[2],P0[3],P0[4],P0[5],     pw0[0]=PKW(P0,0), pw0[1]=PKW(P0,2), pw0); \
    VRD(4); SBAR(); GAPA(C1=__builtin_amdgcn_mfma_f32_32x32x16_bf16(kf[1],qr[0],negm,0,0,0), P0[6],P0[7],P0[8],P0[9],     pw0[2]=PKW(P0,4), pw0[3]=PKW(P0,6), pw0); \
    VRD(1); SBAR(); GAPA(C0=__builtin_amdgcn_mfma_f32_32x32x16_bf16(kf[2],qr[1],C0,0,0,0),   P0[10],P0[11],P0[12],P0[13], pw1[0]=PKW(P0,8), pw1[1]=PKW(P0,10), pw1); \
    VRD(5); SBAR(); GAPA(C1=__builtin_amdgcn_mfma_f32_32x32x16_bf16(kf[3],qr[1],C1,0,0,0),   P0[14],P0[15],P1[0],P1[1],   pw1[2]=PKW(P0,12),pw1[3]=PKW(P0,14), pw1); \
    VRD(2); SBAR(); GAPA(C0=__builtin_amdgcn_mfma_f32_32x32x16_bf16(kf[4],qr[2],C0,0,0,0),   P1[2],P1[3],P1[4],P1[5],     pw2[0]=PKW(P1,0), pw2[1]=PKW(P1,2), pw2); \
    VRD(6); SBAR(); GAPA(C1=__builtin_amdgcn_mfma_f32_32x32x16_bf16(kf[5],qr[2],C1,0,0,0),   P1[6],P1[7],P1[8],P1[9],     pw2[2]=PKW(P1,4), pw2[3]=PKW(P1,6), pw2); \
    VRD(3); SBAR(); GAPA(C0=__builtin_amdgcn_mfma_f32_32x32x16_bf16(kf[6],qr[3],C0,0,0,0),   P1[10],P1[11],P1[12],P1[13], pw3[0]=PKW(P1,8), pw3[1]=PKW(P1,10), pw3); \
    VRD(7); SBAR(); GAPA(C1=__builtin_amdgcn_mfma_f32_32x32x16_bf16(kf[7],qr[3],C1,0,0,0),   P1[14],P1[15],0.f,0.f,       pw3[2]=PKW(P1,12),pw3[3]=PKW(P1,14), pw3); \
    l_reg+=sacc; \
    if(GK){DMA_K((t)+3,sl_cur);} if(GV){DMA_V((t)+1,sl_next);} \
    CMASK(C0,C1,t); \
    SBAR(); \
    const lds_cptr vp2_=vp0+(LDS_V2-LDS_V)+sl_prev; \
    GAPB2(o[0]=__builtin_amdgcn_mfma_f32_32x32x16_bf16(PAF(0),VFR(0),o[0],0,0,0), C0,0); VRD2(0); SBAR(); \
    GAPB2(o[1]=__builtin_amdgcn_mfma_f32_32x32x16_bf16(PAF(0),VFR(4),o[1],0,0,0), C0,2); VRD2(4); SBAR(); \
    KRD(GL,0); GAPB2(o[0]=__builtin_amdgcn_mfma_f32_32x32x16_bf16(PAF(1),VFR(1),o[0],0,0,0), C0,4); VRD2(1); SBAR(); \
    KRD(GL,1); GAPB2(o[1]=__builtin_amdgcn_mfma_f32_32x32x16_bf16(PAF(1),VFR(5),o[1],0,0,0), C0,6); VRD2(5); SBAR(); \
    KRD(GL,2); GAPB2(o[0]=__builtin_amdgcn_mfma_f32_32x32x16_bf16(PAF(2),VFR(2),o[0],0,0,0), C0,8); VRD2(2); SBAR(); \
    KRD(GL,3); GAPB2(o[1]=__builtin_amdgcn_mfma_f32_32x32x16_bf16(PAF(2),VFR(6),o[1],0,0,0), C0,10); VRD2(6); SBAR(); \
    GAPB2(o[0]=__builtin_amdgcn_mfma_f32_32x32x16_bf16(PAF(3),VFR(3),o[0],0,0,0), C0,12); VRD2(3); SBAR(); \
    GAPB2(o[1]=__builtin_amdgcn_mfma_f32_32x32x16_bf16(PAF(3),VFR(7),o[1],0,0,0), C0,14); VRD2(7); SBAR(); \
    GAPB2(o2[0]=__builtin_amdgcn_mfma_f32_32x32x16_bf16(PAF(0),V2FR(0),o2[0],0,0,0), C1,0); \
    GAPB2(o2[1]=__builtin_amdgcn_mfma_f32_32x32x16_bf16(PAF(0),V2FR(4),o2[1],0,0,0), C1,2); \
    GAPB2(o2[0]=__builtin_amdgcn_mfma_f32_32x32x16_bf16(PAF(1),V2FR(1),o2[0],0,0,0), C1,4); \
    GAPB2(o2[1]=__builtin_amdgcn_mfma_f32_32x32x16_bf16(PAF(1),V2FR(5),o2[1],0,0,0), C1,6); \
    GAPB2(o2[0]=__builtin_amdgcn_mfma_f32_32x32x16_bf16(PAF(2),V2FR(2),o2[0],0,0,0), C1,8); \
    GAPB2(o2[1]=__builtin_amdgcn_mfma_f32_32x32x16_bf16(PAF(2),V2FR(6),o2[1],0,0,0), C1,10); \
    GAPB2(o2[0]=__builtin_amdgcn_mfma_f32_32x32x16_bf16(PAF(3),V2FR(3),o2[0],0,0,0), C1,12); \
    GAPB2(o2[1]=__builtin_amdgcn_mfma_f32_32x32x16_bf16(PAF(3),V2FR(7),o2[1],0,0,0), C1,14); \
    }while(0)
  int t=1;
  #undef CMASK
  #define CMASK(P0,P1,t) do{}while(0)
  for(;t+5<NT;t+=2){
    STEP(pB0,pB1,pA0,pA1,t,true,true,true);     WAIT_BAR(3); RESC(); ROT();
    STEP(pA0,pA1,pB0,pB1,t+1,true,true,true);   WAIT_BAR(3); RESC(); ROT();
  }
  #undef CMASK
  #define CMASK(P0,P1,t) do{int jb_=(t)-(NT-4); if(jb_>=0)cmask(P0,P1,jb_,qrel,hi);}while(0)
  #define ENDW(tt) do{ if((tt)+3<NT){WAIT_BAR(3);} else if((tt)+2<NT){WAIT_BAR(2);} else {WAIT_BAR(0);} }while(0)
  for(;t+1<NT;t+=2){
    STEP(pB0,pB1,pA0,pA1,t,(t+3<NT),(t+1<NT),(t+1<NT));       ENDW(t);   RESC(); ROT();
    STEP(pA0,pA1,pB0,pB1,t+1,(t+4<NT),(t+2<NT),(t+2<NT));     ENDW(t+1); RESC(); ROT();
  }
  STEP(pB0,pB1,pA0,pA1,NT-1,false,false,false); RESC();
  { float sacc=pB0[0]+pB0[1]; _Pragma("unroll") for(int r=2;r<16;++r)sacc+=pB0[r]; _Pragma("unroll") for(int r=0;r<16;++r)sacc+=pB1[r]; l_reg+=sacc;
    pw0=(u32x4){PKW(pB0,0),PKW(pB0,2),PKW(pB0,4),PKW(pB0,6)};pw1=(u32x4){PKW(pB0,8),PKW(pB0,10),PKW(pB0,12),PKW(pB0,14)};pw2=(u32x4){PKW(pB1,0),PKW(pB1,2),PKW(pB1,4),PKW(pB1,6)};pw3=(u32x4){PKW(pB1,8),PKW(pB1,10),PKW(pB1,12),PKW(pB1,14)};
    SBAR(); pv(o,vb0+sl_cur,PAF(0),PAF(1),PAF(2),PAF(3)); pv(o2,vb0+(LDS_V2-LDS_V)+sl_cur,PAF(0),PAF(1),PAF(2),PAF(3)); }
  #undef PKW
  #undef PAF
  #undef VFR
  #undef PIN
  #undef MX3
  #undef GAPA
  #undef GAPB
  #undef EX
  #undef VRD
  #undef VRD2
  #undef V2FR
  #undef GAPB2
  #undef KRD
  #undef STEP
  #undef ENDW
  {auto rr=__builtin_amdgcn_permlane32_swap(__float_as_uint(l_reg),__float_as_uint(l_reg),false,false);l_reg=__uint_as_float(rr[0])+__uint_as_float(rr[1]);}
  if(hi==0)wsf[32+r32]=l_reg;asm volatile("s_waitcnt lgkmcnt(0)":::"memory");
  float rli[16];
  #pragma unroll
  for(int r=0;r<16;++r)rli[r]=__builtin_amdgcn_rcpf(wsf[32+crow(r,hi)]);
  bf16*O,*O2,*YA; const float*sw; { unsigned char*w_=wsb; asm volatile("":"+s"(w_)); O=(bf16*)(w_+AWS_OLO); O2=(bf16*)(w_+AWS_OHI); YA=(bf16*)(w_+AWS_YA); sw=(const float*)(w_+AWS_SW); }
  u32x4 mine[2][4];
  #pragma unroll
  for(int ob=0;ob<2;++ob){ bf16*Ow=(ob?O2:O)+(rowbase+q0+wid*QBLK)*DM+h*D;
    bf16*stg=(bf16*)(shm+LDS_OST)+wid*2048;
    #pragma unroll
    for(int r=0;r<16;++r){const int orow=crow(r,hi);
      #pragma unroll
      for(int d0=0;d0<2;++d0)stg[orow*64+d0*32+r32]=__float2bfloat16((ob?o2[d0][r]:o[d0][r])*rli[r]);}
    asm volatile("s_waitcnt lgkmcnt(0)":::"memory");
    #pragma unroll
    for(int i=0;i<4;++i){const int row=i*8+(lane>>3),ch=lane&7; const u32x4 v=*(const u32x4*)(stg+row*64+ch*8); if(CMB==0){ATTN_STORE16(Ow+(long)row*DM+ch*8,v);} else mine[ob][i]=v;}
    asm volatile("s_waitcnt lgkmcnt(0)":::"memory"); }
  if(CMB==1){
    const int ch=lane&7; const bf16*P1lo=O+(rowbase+q0+wid*QBLK)*DM+(h-1)*D+ch*8,*P1hi=O2+(rowbase+q0+wid*QBLK)*DM+(h-1)*D+ch*8;
    float swl[8],swh[8];
    #pragma unroll
    for(int e=0;e<8;++e){swl[e]=sw[ch*8+e];swh[e]=sw[64+ch*8+e];}
    bf16*Yw=YA+(rowbase+q0+wid*QBLK)*(long)ya_pitch+(h>>1)*128+ch*8;
    u32x4 p1[2][4];
    #pragma unroll
    for(int i=0;i<4;++i){const int row=i*8+(lane>>3); p1[0][i]=*(const u32x4*)(P1lo+(long)row*DM); p1[1][i]=*(const u32x4*)(P1hi+(long)row*DM);}
    #pragma unroll
    for(int i=0;i<4;++i){const int row=i*8+(lane>>3); float a_[16]; float ss=0.f;
      #pragma unroll
      for(int t=0;t<2;++t)
        #pragma unroll
        for(int e=0;e<4;++e){const unsigned w1=p1[t][i][e],w2=mine[t][i][e];
          const float x0=__uint_as_float(w1<<16)-lam*__uint_as_float(w2<<16), x1=__uint_as_float(w1&0xffff0000u)-lam*__uint_as_float(w2&0xffff0000u);
          a_[t*8+2*e]=x0;a_[t*8+2*e+1]=x1;ss+=x0*x0+x1*x1;}
      ss+=__shfl_xor(ss,1);ss+=__shfl_xor(ss,2);ss+=__shfl_xor(ss,4);
      const float rn=1.0f/sqrtf(ss*(1.f/128.f)+1e-6f);
      u32x4 ylo,yhi;
      #pragma unroll
      for(int e=0;e<4;++e){ylo[e]=cvtpk_s(a_[2*e]*rn*swl[2*e],a_[2*e+1]*rn*swl[2*e+1]);yhi[e]=cvtpk_s(a_[8+2*e]*rn*swh[2*e],a_[8+2*e+1]*rn*swh[2*e+1]);}
      *(u32x4*)(Yw+(long)row*ya_pitch)=ylo; *(u32x4*)(Yw+(long)row*ya_pitch+64)=yhi; }
  }
  asm volatile("s_waitcnt lgkmcnt(0)\n\ts_barrier":::"memory");
  #undef DMA_K
  #undef DMA_V
  #undef CMASK
  #undef START
  #undef RESC
  #undef ROT
}
constexpr int ATTN_LDS_BYTES=LDS_BYTES;

#undef SBAR
#undef WAIT_BAR
}
#include <hip/hip_cooperative_groups.h>
namespace cg = cooperative_groups;

#define LAS __attribute__((address_space(3)))
typedef unsigned short bf16;
typedef unsigned u32x4v __attribute__((ext_vector_type(4)));
typedef unsigned u32x2v __attribute__((ext_vector_type(2)));
typedef float f32x4 __attribute__((ext_vector_type(4)));
typedef float f32x16v __attribute__((ext_vector_type(16)));
typedef short bf16x8v __attribute__((ext_vector_type(8)));

constexpr int NWAVES = 8, NTHR = NWAVES * 64;
constexpr int BATCH = 4, SEQ = 8192, DMOD = 2048, M = BATCH * SEQ;
constexpr int AW = 1024, FF = 5632, NIN = 8192, NGU = 2 * FF;
constexpr float EPS = 1e-6f;
constexpr int LDS_BYTES = 132096;
constexpr float LOG2E = 1.4426950408889634f;

constexpr size_t MiB = 1u << 20;
constexpr size_t WS_KMAX = 512 * 1024;
constexpr size_t WS_ABAR = 1 * MiB, WS_BF = 1 * MiB + 64 * 1024, WS_CF = 1 * MiB + 512 * 1024;
constexpr size_t WS_WIN = 2 * MiB, WS_WGLU = 34 * MiB, WS_WA = 36 * MiB, WS_WS = 40 * MiB, WS_WOUT = 44 * MiB, WS_WGU = 52 * MiB, WS_WD = 96 * MiB;
constexpr size_t WS_WG8 = 18 * MiB;
constexpr size_t WS_U8 = 768 * MiB;
constexpr int FFN_H8 = 1536, FFN_T8 = FFN_H8 / 128, ACT_PITCH = FFN_H8 + 2 * (FF - FFN_H8);
constexpr float ACT_S8 = 8.f, WD_S8 = 64.f;
constexpr float GATE_WSCALE = 64.f;
constexpr size_t WS_U = 128 * MiB;
constexpr size_t WS_Q = 256 * MiB, WS_K = 320 * MiB, WS_V = 384 * MiB, WS_SIN = 448 * MiB;
constexpr size_t WS_GA = 512 * MiB, WS_GS = 640 * MiB;
constexpr size_t WS_OLO = 768 * MiB, WS_OHI = 832 * MiB, WS_YS = 896 * MiB;
constexpr size_t WS_SW = 768 * 1024;
constexpr size_t WS_YA = 128 * MiB  , WS_YS2 = 320 * MiB, WS_T1 = 384 * MiB, WS_MERGED = 768 * MiB, WS_MIX = 640 * MiB;
constexpr size_t WS_ACT = 256 * MiB, WS_F = 768 * MiB, WS_END = 960 * MiB;

__device__ __forceinline__ float bf_lo(unsigned u) { return __uint_as_float(u << 16); }
__device__ __forceinline__ float bf_hi(unsigned u) { return __uint_as_float(u & 0xffff0000u); }
__device__ __forceinline__ unsigned pkbf(float lo, float hi) { return pg8::cvt_pk_bf16(lo, hi); }
__device__ __forceinline__ float sigmoidf_(float x) { return __builtin_amdgcn_rcpf(1.0f + __builtin_amdgcn_exp2f(-LOG2E * x)); }
__device__ __forceinline__ void unpack8(const u32x4v w, f32x4& lo, f32x4& hi) {
    lo[0] = bf_lo(w.x); lo[1] = bf_hi(w.x); lo[2] = bf_lo(w.y); lo[3] = bf_hi(w.y); hi[0] = bf_lo(w.z); hi[1] = bf_hi(w.z); hi[2] = bf_lo(w.w); hi[3] = bf_hi(w.w); }
__device__ __forceinline__ u32x4v pack8(const f32x4 a, const f32x4 b) { u32x4v w; w.x = pkbf(a[0], a[1]); w.y = pkbf(a[2], a[3]); w.z = pkbf(b[0], b[1]); w.w = pkbf(b[2], b[3]); return w; }
__device__ __forceinline__ float wave_sum(float v) {
#pragma unroll
    for (int o = 1; o < 64; o <<= 1) v += __shfl_xor(v, o);
    return v;
}

__device__ __forceinline__ unsigned pk4_fp8(float a, float b, float cc, float d) { int w = 0; w = __builtin_amdgcn_cvt_pk_fp8_f32(a, b, w, false); w = __builtin_amdgcn_cvt_pk_fp8_f32(cc, d, w, true); return (unsigned)w; }
namespace epi {
using pg8::Unit; using pg8::BM; using pg8::HALF; using pg8::bf16_t;
struct InProj {
    static constexpr bool PERM = true, AFTER_DRAIN = false, MID_HOOK = false;
    unsigned* kmax2;
    bf16_t* qkvs; bf16_t* gates; float qscale; int col_base; float gscale;
    __device__ __forceinline__ void operator()(const pg8::f32x4 (&acc)[2][2][4][2], const Unit& u, int wr, int wc, int fr, int fq) const {
        const int row0 = u.pm * BM + wr * 64 + fr; int colt = col_base + u.pn * BM; bf16_t* base; int ldc; int mode;
        if (colt < 4096) { const int t = colt >> 10; base = qkvs + (size_t)t * ((size_t)M * 1024); ldc = 1024; colt &= 1023; mode = (t == 0) ? 1 : 0; }
        else { const int t = (colt - 4096) >> 11; base = gates + (size_t)t * ((size_t)M * 2048); ldc = 2048; colt = (colt - 4096) & 2047; mode = 2; }
        const int col0 = colt + wc * 32 + 8 * fq;
        if (kmax2 && mode == 0 && (col_base + u.pn * BM) >= 1024 && (col_base + u.pn * BM) < 2048) {
#pragma unroll
            for (int bj = 0; bj < 2; ++bj) { float mx = 0.f;
#pragma unroll
                for (int ai = 0; ai < 2; ++ai)
#pragma unroll
                    for (int m = 0; m < 4; ++m) { const pg8::f32x4 a = acc[ai][bj][m][0], b = acc[ai][bj][m][1];
                        float ss = (a[0] * a[0] + a[1] * a[1]) + (a[2] * a[2] + a[3] * a[3]) + (b[0] * b[0] + b[1] * b[1]) + (b[2] * b[2] + b[3] * b[3]);
                        ss += __shfl_xor(ss, 16); ss += __shfl_xor(ss, 32); mx = fmaxf(mx, ss); }
                mx = fmaxf(mx, __shfl_xor(mx, 1)); mx = fmaxf(mx, __shfl_xor(mx, 2)); mx = fmaxf(mx, __shfl_xor(mx, 4)); mx = fmaxf(mx, __shfl_xor(mx, 8));
                if (fr == 0 && fq == 0) { const int bidx = (u.pm * BM) / SEQ, head = ((colt >> 6) + 2 * bj + (wc >> 1));
                    __hip_atomic_fetch_max(kmax2 + (bidx * 16 + head) * 2 + (wc & 1), __float_as_uint(mx), __ATOMIC_RELAXED, __HIP_MEMORY_SCOPE_AGENT); } }
        }
#pragma unroll
        for (int ai = 0; ai < 2; ++ai)
#pragma unroll
            for (int m = 0; m < 4; ++m) { bf16_t* rowp = base + (size_t)(row0 + ai * HALF + m * 16) * ldc + col0;
#pragma unroll
                for (int bj = 0; bj < 2; ++bj) { pg8::f32x4 v0 = acc[ai][bj][m][0], v1 = acc[ai][bj][m][1];
                    if (mode == 1) { v0 = v0 * qscale; v1 = v1 * qscale; }
                    else if (mode == 2) {
#pragma unroll
                        for (int e = 0; e < 4; ++e) { v0[e] = sigmoidf_(v0[e] * gscale); v1[e] = sigmoidf_(v1[e] * gscale); } }
                    *(u32x4v*)(rowp + bj * HALF) = pack8(v0, v1); } }
    }
};
template <int MODE> struct Ew {
    static constexpr bool PERM = true, AFTER_DRAIN = false, MID_HOOK = false;
    bf16_t* O; int ldc; const bf16_t* aux1; const bf16_t* aux2; const float* bias; int lda;
    __device__ __forceinline__ void operator()(const pg8::f32x4 (&acc)[2][2][4][2], const Unit& u, int wr, int wc, int fr, int fq) const {
        const int row0 = u.pm * BM + wr * 64 + fr; const int col0 = u.pn * BM + wc * 32 + 8 * fq;
        pg8::f32x4 bv[2][2];
#pragma unroll
        for (int bj = 0; bj < 2; ++bj)
#pragma unroll
            for (int n = 0; n < 2; ++n) bv[bj][n] = (MODE == 2) ? *(const pg8::f32x4*)(bias + col0 + bj * HALF + 4 * n) : (pg8::f32x4){0.f, 0.f, 0.f, 0.f};
#pragma unroll
        for (int ai = 0; ai < 2; ++ai)
#pragma unroll
            for (int m = 0; m < 4; ++m) { const size_t ro = (size_t)(row0 + ai * HALF + m * 16) * ldc + col0, rx = (size_t)(row0 + ai * HALF + m * 16) * lda + col0;
#pragma unroll
                for (int bj = 0; bj < 2; ++bj) { const size_t o = ro + bj * HALF, ox = rx + bj * HALF; pg8::f32x4 v0 = acc[ai][bj][m][0], v1 = acc[ai][bj][m][1];
                    if (MODE == 2) { f32x4 a0, a1; unpack8(*(const u32x4v*)(aux1 + ox), a0, a1); v0 = v0 + bv[bj][0]; v1 = v1 + bv[bj][1];
#pragma unroll
                        for (int e = 0; e < 4; ++e) { v0[e] = a0[e] * sigmoidf_(v0[e]); v1[e] = a1[e] * sigmoidf_(v1[e]); } }
                    if (MODE == 3) { f32x4 a0, a1; unpack8(*(const u32x4v*)(aux1 + ox), a0, a1); v0 = v0 * a0; v1 = v1 * a1; }
                    if (MODE == 4) { f32x4 a0, a1, g0, g1; unpack8(*(const u32x4v*)(aux1 + ox), a0, a1); unpack8(*(const u32x4v*)(aux2 + ox), g0, g1); v0 = a0 + g0 * v0; v1 = a1 + g1 * v1; }
                    *(u32x4v*)(O + o) = pack8(v0, v1); } }
    }
};
struct Gated {
    static constexpr bool PERM = true, AFTER_DRAIN = false, MID_HOOK = true;
    bf16_t* O; int ldc; const bf16_t* ga; const bf16_t* gs;
    __device__ __forceinline__ int mid_t(int nt) const { return nt >> 1; }
    __device__ __forceinline__ void mid(pg8::f32x4 (&acc)[2][2][4][2], const Unit& u, int wr, int wc, int fr, int fq) const {
        int row0 = u.pm * BM + wr * 64 + fr; const int col0 = u.pn * BM + wc * 32 + 8 * fq;
        asm volatile("" : "+v"(row0));
#pragma unroll
        for (int ai = 0; ai < 2; ++ai)
#pragma unroll
            for (int m = 0; m < 4; ++m) { const size_t ro = (size_t)(row0 + ai * HALF + m * 16) * ldc + col0;
#pragma unroll
                for (int bj = 0; bj < 2; ++bj) { const size_t o = ro + bj * HALF; f32x4 a0, a1, g0, g1; unpack8(*(const u32x4v*)(ga + o), a0, a1); unpack8(*(const u32x4v*)(gs + o), g0, g1);
#pragma unroll
                    for (int e = 0; e < 4; ++e) { acc[ai][bj][m][0][e] *= a0[e] * __builtin_amdgcn_rcpf(g0[e]); acc[ai][bj][m][1][e] *= a1[e] * __builtin_amdgcn_rcpf(g1[e]); } }
                if (m & 1) asm volatile("" ::: "memory"); }
    }
    __device__ __forceinline__ void operator()(const pg8::f32x4 (&acc)[2][2][4][2], const Unit& u, int wr, int wc, int fr, int fq) const {
        const int row0 = u.pm * BM + wr * 64 + fr; const int col0 = u.pn * BM + wc * 32 + 8 * fq;
#pragma unroll
        for (int ai = 0; ai < 2; ++ai)
#pragma unroll
            for (int m = 0; m < 4; ++m) { const size_t ro = (size_t)(row0 + ai * HALF + m * 16) * ldc + col0;
#pragma unroll
                for (int bj = 0; bj < 2; ++bj) { const size_t o = ro + bj * HALF; f32x4 g0, g1; unpack8(*(const u32x4v*)(gs + o), g0, g1);
                    *(u32x4v*)(O + o) = pack8(acc[ai][bj][m][0] * g0, acc[ai][bj][m][1] * g1); } }
    }
};
struct PlainMix {
    static constexpr bool PERM = true, AFTER_DRAIN = false, MID_HOOK = true;
    bf16_t* O; int ldc; int t8; float undo;
    __device__ __forceinline__ int mid_t(int) const { return t8; }
    __device__ __forceinline__ void mid(pg8::f32x4 (&acc)[2][2][4][2], const Unit&, int, int, int, int) const {
#pragma unroll
        for (int ai = 0; ai < 2; ++ai)
#pragma unroll
            for (int bj = 0; bj < 2; ++bj)
#pragma unroll
                for (int m = 0; m < 4; ++m) { acc[ai][bj][m][0] = acc[ai][bj][m][0] * undo; acc[ai][bj][m][1] = acc[ai][bj][m][1] * undo; }
    }
    __device__ __forceinline__ void operator()(const pg8::f32x4 (&acc)[2][2][4][2], const Unit& u, int wr, int wc, int fr, int fq) const {
        const int row0 = u.pm * BM + wr * 64 + fr; const int col0 = u.pn * BM + wc * 32 + 8 * fq;
#pragma unroll
        for (int ai = 0; ai < 2; ++ai)
#pragma unroll
            for (int m = 0; m < 4; ++m) { const size_t ro = (size_t)(row0 + ai * HALF + m * 16) * ldc + col0;
#pragma unroll
                for (int bj = 0; bj < 2; ++bj) *(u32x4v*)(O + ro + bj * HALF) = pack8(acc[ai][bj][m][0], acc[ai][bj][m][1]); }
    }
};
struct SwiGlu {
    static constexpr bool PERM = true, AFTER_DRAIN = false, MID_HOOK = false;
    unsigned char* O; int pitch; int h8; float s8;
    __device__ __forceinline__ void operator()(const pg8::f32x4 (&acc)[2][2][4][2], const Unit& u, int wr, int wc, int fr, int fq) const {
        const int row0 = u.pm * BM + wr * 64 + fr; const int col0 = u.pn * HALF + wc * 32 + 8 * fq; const bool f8 = (u.pn * HALF) < h8;
#pragma unroll
        for (int ai = 0; ai < 2; ++ai)
#pragma unroll
            for (int m = 0; m < 4; ++m) { pg8::f32x4 g0 = acc[ai][0][m][0], g1 = acc[ai][0][m][1]; const pg8::f32x4 u0 = acc[ai][1][m][0], u1 = acc[ai][1][m][1];
#pragma unroll
                for (int e = 0; e < 4; ++e) { g0[e] = g0[e] * sigmoidf_(g0[e]) * u0[e]; g1[e] = g1[e] * sigmoidf_(g1[e]) * u1[e]; }
                unsigned char* rowp = O + (size_t)(row0 + ai * HALF + m * 16) * pitch;
                if (f8) { u32x2v o; o.x = pk4_fp8(g0[0] * s8, g0[1] * s8, g0[2] * s8, g0[3] * s8); o.y = pk4_fp8(g1[0] * s8, g1[1] * s8, g1[2] * s8, g1[3] * s8); *(u32x2v*)(rowp + col0) = o; }
                else *(u32x4v*)(rowp + h8 + 2 * (col0 - h8)) = pack8(g0, g1); }
    }
};
}

__device__ __forceinline__ void p0_transpose_item(const float* W, int K, int N, bf16* WT, int gu, LAS float* scr, int item, int lane, int ldk = 0, int koff = 0) {
    if (ldk == 0) ldk = K;
    const int nblk = N / 32, kb = item / nblk, nb = item % nblk, k0 = 64 * kb, n0 = 32 * nb;
    int drow0 = n0; if (gu) drow0 = (n0 >> 7) * 256 + (n0 & 127) + (gu == 2 ? 128 : 0);
#pragma unroll 8
    for (int i = 0; i < 32; ++i) { const int kk = 2 * i + (lane >> 5); scr[kk * 33 + (lane & 31)] = __builtin_nontemporal_load(&W[(size_t)(k0 + kk) * N + n0 + (lane & 31)]); }
    asm volatile("s_waitcnt lgkmcnt(0)" ::: "memory");
    const int c = lane & 7;
#pragma unroll
    for (int j = 0; j < 4; ++j) { const int n = (lane >> 3) + 8 * j; const LAS float* s = scr + (8 * c) * 33 + n;
        u32x4v o; o.x = pkbf(s[0 * 33], s[1 * 33]); o.y = pkbf(s[2 * 33], s[3 * 33]); o.z = pkbf(s[4 * 33], s[5 * 33]); o.w = pkbf(s[6 * 33], s[7 * 33]);
        *(u32x4v*)(WT + (size_t)(drow0 + n) * ldk + koff + k0 + 8 * c) = o; }
    asm volatile("s_waitcnt lgkmcnt(0)" ::: "memory");
}
__device__ __forceinline__ void p0_transpose_item_fp8(const float* W, int K, int N, unsigned char* WT, int drow0, float scale, LAS float* scr, int k0, int n0, int lane) {
#pragma unroll 8
    for (int i = 0; i < 32; ++i) { const int kk = 2 * i + (lane >> 5); scr[kk * 33 + (lane & 31)] = __builtin_nontemporal_load(&W[(size_t)(k0 + kk) * N + n0 + (lane & 31)]); }
    asm volatile("s_waitcnt lgkmcnt(0)" ::: "memory");
    const int c = lane & 7;
#pragma unroll
    for (int j = 0; j < 4; ++j) { const int n = (lane >> 3) + 8 * j; const LAS float* s = scr + (8 * c) * 33 + n;
        u32x2v o; o.x = pk4_fp8(s[0 * 33] * scale, s[1 * 33] * scale, s[2 * 33] * scale, s[3 * 33] * scale); o.y = pk4_fp8(s[4 * 33] * scale, s[5 * 33] * scale, s[6 * 33] * scale, s[7 * 33] * scale);
        *(u32x2v*)(WT + (size_t)(drow0 + n) * K + k0 + 8 * c) = o; }
    asm volatile("s_waitcnt lgkmcnt(0)" ::: "memory");
}
__device__ __forceinline__ void rms_row_to_bf16(const float* xrow, const float* w, bf16* orow, unsigned char* orow8, int lane) {
    const f32x4* xr = (const f32x4*)xrow + lane; const f32x4* wr = (const f32x4*)w + lane;
    f32x4 v[8]; float s = 0.f;
#pragma unroll
    for (int j = 0; j < 8; ++j) { v[j] = __builtin_nontemporal_load(&xr[64 * j]); s += (v[j].x * v[j].x + v[j].y * v[j].y) + (v[j].z * v[j].z + v[j].w * v[j].w); }
    const float r = 1.0f / sqrtf(wave_sum(s) * (1.f / DMOD) + EPS);
    u32x2v* o8 = (u32x2v*)orow + lane;
#pragma unroll
    for (int j = 0; j < 8; ++j) { const f32x4 ww = wr[64 * j]; const f32x4 y = v[j] * r * ww; u32x2v o; o.x = pkbf(y.x, y.y); o.y = pkbf(y.z, y.w); o8[64 * j] = o;
        ((unsigned*)orow8)[lane + 64 * j] = pk4_fp8(y.x, y.y, y.z, y.w); }
}
__device__ __forceinline__ double dexp(double x) {
    const double y = x * (1.0 / 64.0); double t = 1.0, s = 1.0;
    for (int k = 1; k <= 14; ++k) { t *= y / (double)k; s += t; }
    for (int i = 0; i < 6; ++i) s *= s;
    return s;
}
__device__ __forceinline__ void dsincos(double th, double& sn, double& cs) {
    const double TWO_PI = 6.283185307179586476925;
    const double r = th - TWO_PI * __builtin_rint(th / TWO_PI), r2 = r * r;
    double ts = r, tc = 1.0; sn = r; cs = 1.0;
    for (int k = 1; k <= 17; ++k) { tc *= -r2 / (double)((2 * k - 1) * (2 * k)); cs += tc; ts *= -r2 / (double)((2 * k) * (2 * k + 1)); sn += ts; }
}
__device__ __forceinline__ void ssm_param(int g, int p, const float* a_re, const float* a_im, const float* log_dt, const float* b_re, const float* b_im, const float* c_re, const float* c_im,
                                          float* ABAR, bf16* BF, bf16* CF) {
    const double dt = dexp((double)log_dt[g]);
    const double lr = (double)a_re[g * 64 + p], li = (double)a_im[g * 64 + p];
    const double mag = dexp(lr * dt); double sn, cs; dsincos(li * dt, sn, cs);
    const double ar = mag * cs, ai = mag * sn;
    ABAR[(g * 64 + p) * 2 + 0] = (float)ar; ABAR[(g * 64 + p) * 2 + 1] = (float)ai;
    const double nr = ar - 1.0, ni = ai, den = lr * lr + li * li;
    const double cr = (nr * lr + ni * li) / den, ci = (ni * lr - nr * li) / den;
    const int n = p >> 1, jodd = p & 1;
    for (int h = 0; h < 16; ++h) {
        const double br = (double)b_re[(g * 64 + p) * 16 + h], bi = (double)b_im[(g * 64 + p) * 16 + h];
        const float bbr = (float)(cr * br - ci * bi), bbi = (float)(cr * bi + ci * br);
        const int hi = h >> 3, jj = h & 7;
        BF[((size_t)(g * 4 + 0 + jodd) * 64 + (n + 32 * hi)) * 8 + jj] = (bf16)(pkbf(bbr, 0.f) & 0xffffu);
        BF[((size_t)(g * 4 + 2 + jodd) * 64 + (n + 32 * hi)) * 8 + jj] = (bf16)(pkbf(bbi, 0.f) & 0xffffu);
    }
    for (int comp = 0; comp < 2; ++comp) { const int k = p + 64 * comp, kk = k >> 5, kg = (k >> 3) & 3, jj = k & 7;
        for (int ch = 0; ch < 16; ++ch) { const float v = comp == 0 ? c_re[(g * 16 + ch) * 64 + p] : -c_im[(g * 16 + ch) * 64 + p];
            CF[((size_t)(g * 4 + kk) * 64 + (ch + 16 * kg)) * 8 + jj] = (bf16)(pkbf(v, 0.f) & 0xffffu); } }
}

__device__ __forceinline__ float gelu_tanh(float x) { const float z = 0.7978845608028654f * (x + 0.044715f * x * x * x); return x * sigmoidf_(2.0f * z); }
__device__ __forceinline__ void ssm_phase(LAS unsigned char* lds, const bf16* SIN, const float* ABAR, const bf16* BF, const bf16* CF, const float* dskip, bf16* YS, int wid, int lane, int G) {
    typedef float f32x2v __attribute__((ext_vector_type(2)));
    LAS f32x2v* END = (LAS f32x2v*)lds;
    LAS unsigned char* tile = lds + 8192 + wid * 8704;
    const int n = lane & 31, hi = lane >> 5;
    for (int unit = blockIdx.x; unit < BATCH * 64; unit += G) {
        const int b = unit >> 6, g = unit & 63;
        const f32x2v aA = *(const f32x2v*)(ABAR + (g * 64 + 2 * n) * 2), aB = *(const f32x2v*)(ABAR + (g * 64 + 2 * n + 1) * 2);
        bf16x8v bfr[4], cfr[4];
#pragma unroll
        for (int j = 0; j < 4; ++j) { bfr[j] = *(const bf16x8v*)(BF + ((size_t)(g * 4 + j) * 64 + lane) * 8); cfr[j] = *(const bf16x8v*)(CF + ((size_t)(g * 4 + j) * 64 + lane) * 8); }
        const int aseg = (n >> 2) & 1, atok = (n & 3) + 4 * (n >> 3);
        const bf16* uptr = SIN + ((size_t)b * SEQ + (size_t)(2 * wid + aseg) * 512 + atok) * 1024 + g * 16 + 8 * hi;
        float sAr = 0.f, sAi = 0.f, sBr = 0.f, sBi = 0.f;
        const f32x16v zero16 = {0.f, 0.f, 0.f, 0.f, 0.f, 0.f, 0.f, 0.f, 0.f, 0.f, 0.f, 0.f, 0.f, 0.f, 0.f, 0.f};
#define SSM_SCAN(r) { const float nAr = fmaf(-aA.y, sAi, fmaf(aA.x, sAr, D0[r])), nAi = fmaf(aA.y, sAr, fmaf(aA.x, sAi, D2[r])); \
                      const float nBr = fmaf(-aB.y, sBi, fmaf(aB.x, sBr, D1[r])), nBi = fmaf(aB.y, sBr, fmaf(aB.x, sBi, D3[r])); sAr = nAr; sAi = nAi; sBr = nBr; sBi = nBi; }
        {
            bf16x8v ua = *(const bf16x8v*)uptr;
            for (int it = 0; it < 32; ++it) {
                const bf16x8v un = *(const bf16x8v*)(uptr + (size_t)((it + 1 < 32) ? it + 1 : it) * 16 * 1024);
                const f32x16v D0 = __builtin_amdgcn_mfma_f32_32x32x16_bf16(ua, bfr[0], zero16, 0, 0, 0), D1 = __builtin_amdgcn_mfma_f32_32x32x16_bf16(ua, bfr[1], zero16, 0, 0, 0);
                const f32x16v D2 = __builtin_amdgcn_mfma_f32_32x32x16_bf16(ua, bfr[2], zero16, 0, 0, 0), D3 = __builtin_amdgcn_mfma_f32_32x32x16_bf16(ua, bfr[3], zero16, 0, 0, 0);
#pragma unroll
                for (int r = 0; r < 16; ++r) SSM_SCAN(r)
                ua = un;
            }
        }
        END[(2 * wid + hi) * 64 + 2 * n] = (f32x2v){sAr, sAi}; END[(2 * wid + hi) * 64 + 2 * n + 1] = (f32x2v){sBr, sBi};
        __syncthreads();
        {
            f32x2v pA = aA, pB = aB;
#pragma unroll
            for (int i = 0; i < 9; ++i) { pA = (f32x2v){pA.x * pA.x - pA.y * pA.y, 2.f * pA.x * pA.y}; pB = (f32x2v){pB.x * pB.x - pB.y * pB.y, 2.f * pB.x * pB.y}; }
            sAr = 0.f; sAi = 0.f; sBr = 0.f; sBi = 0.f; const int myseg = 2 * wid + hi;
            for (int j = 0; j < 15; ++j) if (j < myseg) { const f32x2v eA = END[j * 64 + 2 * n], eB = END[j * 64 + 2 * n + 1];
                const float tAr = pA.x * sAr - pA.y * sAi + eA.x, tAi = pA.x * sAi + pA.y * sAr + eA.y, tBr = pB.x * sBr - pB.y * sBi + eB.x, tBi = pB.x * sBi + pB.y * sBr + eB.y;
                sAr = tAr; sAi = tAi; sBr = tBr; sBi = tBi; }
        }
        {
            const int tk = lane & 15, q4 = lane >> 4;
            const f32x4 dsk = *(const f32x4*)(dskip + g * 16 + 4 * q4);
            const size_t erow0 = (size_t)b * SEQ + (size_t)(2 * wid) * 512 + tk;
            bf16x8v ua = *(const bf16x8v*)uptr;
            for (int it = 0; it < 32; ++it) {
                const bf16x8v un = *(const bf16x8v*)(uptr + (size_t)((it + 1 < 32) ? it + 1 : it) * 16 * 1024);
                u32x2v uu[2];
#pragma unroll
                for (int s = 0; s < 2; ++s) uu[s] = *(const u32x2v*)(SIN + (erow0 + (size_t)s * 512 + (size_t)it * 16) * 1024 + g * 16 + 4 * q4);
                const f32x16v D0 = __builtin_amdgcn_mfma_f32_32x32x16_bf16(ua, bfr[0], zero16, 0, 0, 0), D1 = __builtin_amdgcn_mfma_f32_32x32x16_bf16(ua, bfr[1], zero16, 0, 0, 0);
                const f32x16v D2 = __builtin_amdgcn_mfma_f32_32x32x16_bf16(ua, bfr[2], zero16, 0, 0, 0), D3 = __builtin_amdgcn_mfma_f32_32x32x16_bf16(ua, bfr[3], zero16, 0, 0, 0);
#pragma unroll
                for (int r = 0; r < 16; ++r) { SSM_SCAN(r)
                    *(LAS unsigned*)(tile + (hi * 16 + r) * 272 + 4 * n) = pkbf(sAr, sBr); *(LAS unsigned*)(tile + (hi * 16 + r) * 272 + 128 + 4 * n) = pkbf(sAi, sBi); }
                asm volatile("s_waitcnt lgkmcnt(0)" ::: "memory");
#pragma unroll
                for (int s = 0; s < 2; ++s) {
                    f32x4 Y = {0.f, 0.f, 0.f, 0.f};
#pragma unroll
                    for (int kk = 0; kk < 4; ++kk) { const bf16x8v sf = *(const LAS bf16x8v*)(tile + (s * 16 + tk) * 272 + (32 * kk + 8 * q4) * 2);
                        Y = __builtin_amdgcn_mfma_f32_16x16x32_bf16(cfr[kk], sf, Y, 0, 0, 0); }
                    const float u0 = bf_lo(uu[s].x), u1 = bf_hi(uu[s].x), u2 = bf_lo(uu[s].y), u3 = bf_hi(uu[s].y);
                    const float y0 = gelu_tanh(Y[0] + dsk[0] * u0), y1 = gelu_tanh(Y[1] + dsk[1] * u1), y2 = gelu_tanh(Y[2] + dsk[2] * u2), y3 = gelu_tanh(Y[3] + dsk[3] * u3);
                    u32x2v o; o.x = pkbf(y0, y1); o.y = pkbf(y2, y3);
                    *(u32x2v*)(YS + (erow0 + (size_t)s * 512 + (size_t)it * 16) * 1024 + g * 16 + 4 * q4) = o;
                }
                asm volatile("s_waitcnt lgkmcnt(0)" ::: "memory");
                ua = un;
            }
        }
#undef SSM_SCAN
        __syncthreads();
    }
}

#define XB_TMO      128
#define XB_XCNT(j)  (256  + 64 * (j))
#define XB_XSUB(j)  (1280 + 64 * (j))
#define XB_XGEN(j)  (2304 + 64 * (j))
#define XB_TOP      3328
#define XB_TOPGEN   3392
#define XCD_BAR_WORDS 3456
#define XB_SPIN_CAP (1u << 18)

__device__ __forceinline__ unsigned xb_ld(unsigned* p)              { return __hip_atomic_load(p, __ATOMIC_RELAXED, __HIP_MEMORY_SCOPE_AGENT); }
__device__ __forceinline__ unsigned xb_add(unsigned* p, unsigned v) { return __hip_atomic_fetch_add(p, v, __ATOMIC_RELAXED, __HIP_MEMORY_SCOPE_AGENT); }
__device__ __forceinline__ unsigned xb_xcc_id() { return (unsigned)__builtin_amdgcn_s_getreg((3 << 11) | 20) & 0xFu; }
#define XB_SPIN(cond, bar) do { unsigned _sp = 0; while (cond) { __builtin_amdgcn_s_sleep(1); \
    if ((++_sp & 255u) == 0u) { if (xb_ld(&(bar)[XB_TMO])) break; if (_sp > XB_SPIN_CAP) { atomicAdd(&(bar)[XB_TMO], 1u); break; } } } } while (0)

struct XcdBarrier {
    unsigned* bar; unsigned x;
    volatile LAS unsigned* st;
};

__device__ __forceinline__ XcdBarrier xcd_barrier_post(unsigned* bar, volatile LAS unsigned* st) {
    XcdBarrier b; b.bar = bar; b.x = xb_xcc_id(); b.st = st;
    if (threadIdx.x == 0) (void)xb_add(&bar[XB_XCNT(b.x)], 1u);
    return b;
}
__device__ __forceinline__ void xcd_barrier_complete(unsigned* bar, unsigned x, unsigned& nloc, unsigned& nx) {
    const unsigned G = gridDim.x * gridDim.y * gridDim.z;
    unsigned sum, cnt, mine, sp = 0u;
    for (;;) {
        sum = 0u; cnt = 0u; mine = 0u;
#pragma unroll
        for (unsigned j = 0; j < 16; ++j) { const unsigned c = xb_ld(&bar[XB_XCNT(j)]); sum += c; cnt += (c > 0u) ? 1u : 0u; mine = (j == x) ? c : mine; }
        if (sum == G) break;
        __builtin_amdgcn_s_sleep(1);
        if ((++sp & 255u) == 0u) { if (xb_ld(&bar[XB_TMO])) break; if (sp > XB_SPIN_CAP) { atomicAdd(&bar[XB_TMO], 1u); break; } }
    }
    nloc = mine > 0u ? mine : 1u; nx = cnt > 0u ? cnt : 1u;
}

__device__ __forceinline__ void xcd_barrier(const XcdBarrier& b) {
    asm volatile("s_waitcnt vmcnt(0)" ::: "memory");
    __syncthreads();
    if (threadIdx.x == 0) {
        unsigned* bar = b.bar;
        __builtin_amdgcn_s_waitcnt(0);
        unsigned nloc = b.st[0], nx = b.st[1];
        if (nloc == 0u) { xcd_barrier_complete(bar, b.x, nloc, nx); b.st[0] = nloc; b.st[1] = nx; }
        const unsigned old = xb_add(&bar[XB_XSUB(b.x)], 1u);
        const unsigned gen = old / nloc;
        if (old + 1u == (gen + 1u) * nloc) {
            __builtin_amdgcn_fence(__ATOMIC_RELEASE, "agent");
            asm volatile("s_waitcnt vmcnt(0)" ::: "memory");
            const unsigned og = xb_add(&bar[XB_TOP], 1u);
            const unsigned tg = og / nx;
            if (og + 1u == (tg + 1u) * nx) xb_add(&bar[XB_TOPGEN], 1u);
            else XB_SPIN(xb_ld(&bar[XB_TOPGEN]) == tg, bar);
            __builtin_amdgcn_fence(__ATOMIC_ACQUIRE, "agent");
            xb_add(&bar[XB_XGEN(b.x)], 1u);
            asm volatile("s_waitcnt vmcnt(0)" ::: "memory");
        } else {
            XB_SPIN(xb_ld(&bar[XB_XGEN(b.x)]) == gen, bar);
            __builtin_amdgcn_fence(__ATOMIC_ACQUIRE, "agent");
            asm volatile("s_waitcnt vmcnt(0)" ::: "memory");
        }
    }
    __syncthreads();
}

struct Args { const float* in[27]; float* out; unsigned char* ws; };
typedef __attribute__((address_space(4))) const Args* KArgs;
__device__ __forceinline__ KArgs kargs_now() { KArgs p = (KArgs)__builtin_amdgcn_kernarg_segment_ptr(); asm volatile("" : "+s"(p)); return p; }
#define WSP(off) ((bf16*)(ws + (off)))
__global__ void __launch_bounds__(NTHR, 2) fwd_megakernel(Args args_unused) {
    extern __shared__ __attribute__((aligned(16))) unsigned char lds_raw[];
    cg::grid_group grid = cg::this_grid();
    LAS unsigned char* lds = (LAS unsigned char*)lds_raw;
    volatile LAS unsigned* xst = (volatile LAS unsigned*)(lds + 131072);
    if (threadIdx.x < 2) xst[threadIdx.x] = 0u;
    __syncthreads();
#define PH_COMMON  const KArgs A = kargs_now(); unsigned char* const ws = A->ws; const int tid = tid_now(), lane = tid & 63, wave = __builtin_amdgcn_readfirstlane(tid >> 6); \
    const int G = gridDim.x, bx = blockIdx.x; const int vcu = (G % 8 == 0) ? (bx % 8) * (G / 8) + bx / 8 : bx; const int gw = vcu * NWAVES + wave, NGW = G * NWAVES; \
    (void)ws; (void)lane; (void)wave; (void)vcu; (void)gw; (void)NGW;

    {
        PH_COMMON
        LAS float* scr = (LAS float*)(lds + wave * 16384);
        constexpr int I0 = (2048 / 64) * (NIN / 32), I1 = (1024 / 64) * (1024 / 32), I2 = (1024 / 64) * (2048 / 32), I3 = I2, I4 = (2048 / 64) * (2048 / 32),
                      I5 = (2048 / 64) * (FF / 32), I6 = I5, I7 = (FF / 64) * (2048 / 32);
        constexpr int NITEMS = I0 + I1 + I2 + I3 + I4 + I5 + I6 + I7;
        for (int it = gw; it < NITEMS; it += NGW) {
            int r = it;
            if (r < I0) { const int nb = r % (NIN / 32), kb = r / (NIN / 32);
                if (nb < 128) p0_transpose_item(A->in[1], 2048, NIN, WSP(WS_WIN), 0, scr, r, lane);
                else p0_transpose_item_fp8(A->in[1], 2048, NIN, ws + WS_WG8, 32 * nb - 4096, GATE_WSCALE, scr, 64 * kb, 32 * nb, lane);
                continue; } r -= I0;
            if (r < I1) { p0_transpose_item(A->in[15], 1024, 1024, WSP(WS_WGLU), 0, scr, r, lane); continue; } r -= I1;
            if (r < I2) { p0_transpose_item(A->in[17], 1024, 2048, WSP(WS_WA), 0, scr, r, lane, 2048, 0); continue; } r -= I2;
            if (r < I3) { p0_transpose_item(A->in[18], 1024, 2048, WSP(WS_WA), 0, scr, r, lane, 2048, 1024); continue; } r -= I3;
            if (r < I4) { p0_transpose_item(A->in[19], 2048, 2048, WSP(WS_WOUT), 0, scr, r, lane); continue; } r -= I4;
            if (r < I5) { p0_transpose_item(A->in[22], 2048, FF, WSP(WS_WGU), 1, scr, r, lane); continue; } r -= I5;
            if (r < I6) { p0_transpose_item(A->in[23], 2048, FF, WSP(WS_WGU), 2, scr, r, lane); continue; } r -= I6;
            { const int nb = r % 64, kb = r / 64;
              if (64 * kb < FFN_H8) p0_transpose_item_fp8(A->in[24], ACT_PITCH, 2048, ws + WS_WD, 32 * nb, WD_S8, scr, 64 * kb, 32 * nb, lane);
              else p0_transpose_item(A->in[24], FF, 2048, WSP(WS_WD), 0, scr, r, lane, ACT_PITCH / 2, -(FFN_H8 / 2)); }
        }
        const float* x = A->in[0]; const float* wpre = A->in[20]; bf16* U = WSP(WS_U);
        for (int m = gw; m < M; m += NGW) rms_row_to_bf16(x + (size_t)m * DMOD, wpre, U + (size_t)m * DMOD, ws + WS_U8 + (size_t)m * DMOD, lane);
        if (bx == 0 && tid < 128) ((unsigned*)(ws + WS_KMAX))[tid] = 0u;
        if (bx == 1 && tid < 128) ((float*)(ws + WS_SW))[tid] = A->in[6][tid] * 0.8f;
        if (bx == 0) for (int i = tid; i < XCD_BAR_WORDS; i += NTHR) ((unsigned*)ws)[i] = 0u;
        const int gt = bx * NTHR + tid;
        if (gt < 64 * 64) ssm_param(gt >> 6, gt & 63, A->in[7], A->in[8], A->in[9], A->in[10], A->in[11], A->in[12], A->in[13], (float*)(ws + WS_ABAR), WSP(WS_BF), WSP(WS_CF));
    }
    grid.sync();
    XcdBarrier xbar;
    { const KArgs A0 = kargs_now(); xbar = xcd_barrier_post((unsigned*)A0->ws, xst); }

    {
        PH_COMMON
        pg8::StaticOrder S; S.init(M, 4096, G, bx);
        pg8::Gemm g{WSP(WS_U), WSP(WS_WIN), M, 4096, 2048};
        epi::InProj E{(unsigned*)(ws + WS_KMAX), WSP(WS_Q), WSP(WS_GA), attn_body::C2, 0, 1.f};
        pg8::gemm_phase<epi::InProj, pg8::StaticOrder, true, true>(lds, g, S, E);
    }
    {
        PH_COMMON
        pg8::StaticOrder S; S.init(M, 4096, G, bx);
        pg8::Gemm g{(const bf16*)(ws + WS_U8), (const bf16*)(ws + WS_WG8), M, 4096, 1024};
        epi::InProj E{nullptr, WSP(WS_Q), WSP(WS_GA), attn_body::C2, 4096, 1.f / GATE_WSCALE};
        pg8::gemm_phase<epi::InProj, pg8::StaticOrder, true, true, true>(lds, g, S, E);
    }
    xcd_barrier(xbar);

    {
        PH_COMMON
        ssm_phase(lds, WSP(WS_SIN), (const float*)(ws + WS_ABAR), WSP(WS_BF), WSP(WS_CF), A->in[14], WSP(WS_YS), wave, lane, G);
    }
    {
        PH_COMMON
        const float d1 = wave_sum(A->in[2][lane] * A->in[3][lane]), d2 = wave_sum(A->in[4][lane] * A->in[5][lane]);
        const float lam = __uint_as_float(__builtin_amdgcn_readfirstlane(__float_as_uint(__expf(d1) - __expf(d2) + 0.2f)));
        static_assert(AWS_Q == WS_Q && AWS_K == WS_K && AWS_V == WS_V && AWS_OLO == WS_OLO && AWS_OHI == WS_OHI && AWS_YA == WS_YA && AWS_SW == WS_SW, "attention body offsets vs d_ws map");
        for (int w = vcu; w < 256; w += G) {
            const int bhd = w >> 3, s = w & 7, b = bhd >> 3, hd = bhd & 7;
            for (int j = 0; j < 4; ++j) { const int qb = (j == 0) ? s : (j == 1) ? 15 - s : (j == 2) ? 16 + s : 31 - s;
#pragma unroll 1
                for (int cmap = 0; cmap < 2; ++cmap) { const int hh = 2 * hd + cmap, bh = b * 16 + hh;
                    const float kmax = 1.01f * sqrtf(__uint_as_float(__builtin_amdgcn_readfirstlane(__hip_atomic_load((unsigned*)(ws + WS_KMAX) + 2 * bh, __ATOMIC_RELAXED, __HIP_MEMORY_SCOPE_AGENT)))
                                                   + __uint_as_float(__builtin_amdgcn_readfirstlane(__hip_atomic_load((unsigned*)(ws + WS_KMAX) + 2 * bh + 1, __ATOMIC_RELAXED, __HIP_MEMORY_SCOPE_AGENT))));
                    attn_body::attn_unit<8>(b, hh, qb, ws, (char*)lds_raw, kmax, cmap, lam); } }
        }
    }
    xcd_barrier(xbar);

    {
        PH_COMMON
        pg8::Gemm g{WSP(WS_YS), WSP(WS_WGLU), M, 1024, 1024}; pg8::StaticOrder S; S.init(M, 1024, G, bx);
        epi::Ew<2> E{WSP(WS_YA) + 1024, 2048, WSP(WS_YS), nullptr, A->in[16], 1024};
        pg8::gemm_phase<epi::Ew<2>, pg8::StaticOrder, true, true>(lds, g, S, E);
    }
    xcd_barrier(xbar);

    {
        PH_COMMON
        pg8::Gemm g{WSP(WS_YA), WSP(WS_WA), M, 2048, 2048}; pg8::StaticOrder S; S.init(M, 2048, G, bx);
        epi::Gated E{WSP(WS_MERGED), 2048, WSP(WS_GA), WSP(WS_GS)};
        pg8::gemm_phase<epi::Gated, pg8::StaticOrder, true, true>(lds, g, S, E);
    }
    xcd_barrier(xbar);
    {
        PH_COMMON
        pg8::Gemm g{WSP(WS_MERGED), WSP(WS_WOUT), M, 2048, 2048}; pg8::StaticOrder S; S.init(M, 2048, G, bx);
        epi::Ew<0> E{WSP(WS_MIX), 2048, nullptr, nullptr, nullptr, 0};
        pg8::gemm_phase<epi::Ew<0>, pg8::StaticOrder, true, true>(lds, g, S, E);
    }
    xcd_barrier(xbar);
    {
        PH_COMMON
        bf16* Z = WSP(WS_U); const bf16* MIX = WSP(WS_MIX); const float* x = A->in[0]; const float* wpost = A->in[21]; const float* wpre2 = A->in[25];
        for (int m = gw; m < M; m += NGW) {
            const f32x4* xr = (const f32x4*)(x + (size_t)m * DMOD) + lane; const u32x2v* mr = (const u32x2v*)(MIX + (size_t)m * DMOD) + lane;
            f32x4 xv[8], mv[8]; float ss = 0.f;
#pragma unroll
            for (int j = 0; j < 8; ++j) { xv[j] = __builtin_nontemporal_load(&xr[64 * j]); const u32x2v w = mr[64 * j]; mv[j] = (f32x4){bf_lo(w.x), bf_hi(w.x), bf_lo(w.y), bf_hi(w.y)};
                ss += (mv[j].x * mv[j].x + mv[j].y * mv[j].y) + (mv[j].z * mv[j].z + mv[j].w * mv[j].w); }
            const float r1 = 1.0f / sqrtf(wave_sum(ss) * (1.f / DMOD) + EPS); float s2 = 0.f;
#pragma unroll
            for (int j = 0; j < 8; ++j) { const f32x4 w1 = ((const f32x4*)wpost)[lane + 64 * j]; xv[j] = xv[j] + mv[j] * r1 * w1;
                s2 += (xv[j].x * xv[j].x + xv[j].y * xv[j].y) + (xv[j].z * xv[j].z + xv[j].w * xv[j].w); }
            const float r2 = 1.0f / sqrtf(wave_sum(s2) * (1.f / DMOD) + EPS);
            u32x2v* zr = (u32x2v*)(Z + (size_t)m * DMOD) + lane;
#pragma unroll
            for (int j = 0; j < 8; ++j) { const f32x4 w2 = ((const f32x4*)wpre2)[lane + 64 * j]; const f32x4 y = xv[j] * r2 * w2; u32x2v o; o.x = pkbf(y.x, y.y); o.y = pkbf(y.z, y.w); zr[64 * j] = o; }
        }
    }
    xcd_barrier(xbar);
    {
        PH_COMMON
        pg8::Gemm g{WSP(WS_U), WSP(WS_WGU), M, NGU, 2048}; pg8::StaticOrder S; S.init(M, NGU, G, bx);
        epi::SwiGlu E{ws + WS_ACT, ACT_PITCH, FFN_H8, ACT_S8};
        pg8::gemm_phase<epi::SwiGlu, pg8::StaticOrder, true, true>(lds, g, S, E);
    }
    xcd_barrier(xbar);
    {
        PH_COMMON
        pg8::Gemm g{WSP(WS_ACT), WSP(WS_WD), M, 2048, ACT_PITCH / 2, FFN_T8}; pg8::StaticOrder S; S.init(M, 2048, G, bx);
        epi::PlainMix E{WSP(WS_F), 2048, FFN_T8, 1.f / (ACT_S8 * WD_S8)};
        pg8::gemm_phase<epi::PlainMix, pg8::StaticOrder, true, true, false, true>(lds, g, S, E);
    }
    xcd_barrier(xbar);
    {
        PH_COMMON
        float* out = A->out; const float* x = A->in[0]; const bf16* MIX = WSP(WS_MIX); const bf16* Fb = WSP(WS_F); const float* wpost = A->in[21]; const float* wpost2 = A->in[26];
        for (int m = gw; m < M; m += NGW) {
            const f32x4* xr = (const f32x4*)(x + (size_t)m * DMOD) + lane; const u32x2v* mr = (const u32x2v*)(MIX + (size_t)m * DMOD) + lane; const u32x2v* fr = (const u32x2v*)(Fb + (size_t)m * DMOD) + lane;
            f32x4 xv[8], mv[8], fv[8]; float ss = 0.f, sf = 0.f;
#pragma unroll
            for (int j = 0; j < 8; ++j) { xv[j] = __builtin_nontemporal_load(&xr[64 * j]); const u32x2v w = __builtin_nontemporal_load(&mr[64 * j]); mv[j] = (f32x4){bf_lo(w.x), bf_hi(w.x), bf_lo(w.y), bf_hi(w.y)};
                const u32x2v wf = __builtin_nontemporal_load(&fr[64 * j]); fv[j] = (f32x4){bf_lo(wf.x), bf_hi(wf.x), bf_lo(wf.y), bf_hi(wf.y)};
                ss += (mv[j].x * mv[j].x + mv[j].y * mv[j].y) + (mv[j].z * mv[j].z + mv[j].w * mv[j].w);
                sf += (fv[j].x * fv[j].x + fv[j].y * fv[j].y) + (fv[j].z * fv[j].z + fv[j].w * fv[j].w); }
            const float r1 = 1.0f / sqrtf(wave_sum(ss) * (1.f / DMOD) + EPS), r3 = 1.0f / sqrtf(wave_sum(sf) * (1.f / DMOD) + EPS);
            f32x4* orow = (f32x4*)(out + (size_t)m * DMOD) + lane;
#pragma unroll
            for (int j = 0; j < 8; ++j) { const f32x4 w1 = ((const f32x4*)wpost)[lane + 64 * j], w3 = ((const f32x4*)wpost2)[lane + 64 * j];
                const f32x4 h = xv[j] + mv[j] * r1 * w1; __builtin_nontemporal_store(h + fv[j] * r3 * w3, &orow[64 * j]); }
        }
    }
}

extern "C" void kernel_launch(void* const* d_in, const int* in_sizes, int n_in, void* d_out, int out_size, void* d_ws, size_t ws_size, hipStream_t stream) {
    static int grid = 0;
    if (grid == 0) {
        if (n_in != 27 || in_sizes[0] != M * DMOD || out_size != M * DMOD || ws_size < WS_END) {
            fprintf(stderr, "kernel_launch: unexpected shapes: n_in %d in0 %d out %d ws %zu (need %zu)\n", n_in, n_in > 0 ? in_sizes[0] : -1, out_size, ws_size, (size_t)WS_END); grid = -1; return; }
        int dev = 0, cus = 0, per_cu = 0;
        (void)hipGetDevice(&dev); (void)hipDeviceGetAttribute(&cus, hipDeviceAttributeMultiprocessorCount, dev);
        if (hipFuncSetAttribute((const void*)fwd_megakernel, hipFuncAttributeMaxDynamicSharedMemorySize, LDS_BYTES) != hipSuccess) { fprintf(stderr, "kernel_launch: hipFuncSetAttribute failed\n"); grid = -1; return; }
        if (hipOccupancyMaxActiveBlocksPerMultiprocessor(&per_cu, (const void*)fwd_megakernel, NTHR, LDS_BYTES) != hipSuccess || per_cu < 1) { fprintf(stderr, "kernel_launch: occupancy query says %d\n", per_cu); per_cu = 1; }
        (void)hipGetLastError();
        grid = cus * per_cu;
    }
    if (grid < 0) return;
    Args a{};
    for (int i = 0; i < 27; ++i) a.in[i] = (const float*)d_in[i];
    a.out = (float*)d_out; a.ws = (unsigned char*)d_ws;
    void* kargs[] = {&a};
    const hipError_t e = hipLaunchCooperativeKernel((const void*)fwd_megakernel, dim3(grid), dim3(NTHR), kargs, LDS_BYTES, stream);
    if (e != hipSuccess) fprintf(stderr, "kernel_launch: cooperative launch failed: %s (grid %d)\n", hipGetErrorString(e), grid);
}
```
